# Optimizing an MI355X kernel written in HIP

```python
import jax, jax.numpy as jnp
from jax import lax
import numpy as np

D_MODEL = 1024
BATCH = 2
SEQ = 8192
DEPTH = 1

PLE_DIM = 256
HEAD_DIM = 64
RWKV_HEADS = 8
RWKV_DIM = RWKV_HEADS * HEAD_DIM
W_LORA = 64
A_LORA = 64
G_LORA = 128
ATTN_GROUPS = ((128, 1), (512, 4), (2048, 16))
HEADS_PER_GROUP = 8
ATTN_HEADS = HEADS_PER_GROUP * len(ATTN_GROUPS)
ATTN_DIM = ATTN_HEADS * HEAD_DIM
ATTN_OUT_DIM = HEADS_PER_GROUP * HEAD_DIM
Q_BLOCK = 128
N_BRANCHES = 2
RWKV_COLS = 3 * RWKV_DIM + W_LORA + A_LORA + G_LORA
ATTN_COLS = 3 * ATTN_DIM
GATE_COLS = N_BRANCHES * D_MODEL
IN_COLS = RWKV_COLS + ATTN_COLS + GATE_COLS
N_EXPERT_GROUPS = 4
EXPERTS_PER_GROUP = 8
TOP_K_EXPERT = 2
D_FF_EXPERT = 256
NORM_EPS = 1e-6
RWKV_GN_EPS = 64e-5

kernel_name = "hybrid_rwkv7_dilated_alibi_hmoe_block"


def rmsnorm(x, gain):
    x32 = x.astype(jnp.float32)
    return x32 * lax.rsqrt(jnp.mean(x32 * x32, axis=-1, keepdims=True) + NORM_EPS) * gain


def token_shift(t, mu):
    prev = jnp.pad(t[:, :-1], ((0, 0), (1, 0), (0, 0)))
    return t + (prev - t) * mu


def wkv7_scan(r, decay, k, v, kk, a):
    b, s, h, n = r.shape

    def step(state, inp):
        r_t, w_t, k_t, v_t, kk_t, a_t = inp
        sa = jnp.einsum('bhij,bhj->bhi', state, -kk_t)
        state = (state * w_t[:, :, None, :]
                 + sa[..., :, None] * (kk_t * a_t)[:, :, None, :]
                 + v_t[..., :, None] * k_t[:, :, None, :])
        y = jnp.einsum('bhij,bhj->bhi', state, r_t)
        return state, y

    xs = tuple(jnp.moveaxis(t, 1, 0) for t in (r, decay, k, v, kk, a))
    state0 = jnp.zeros((b, h, n, n), jnp.float32)
    _, ys = lax.scan(step, state0, xs)
    return jnp.moveaxis(ys, 0, 1)


def rwkv7_time_mix(z, w0, w2, a0, a2, g2, k_k, k_a, r_k, ln_w, ln_b):
    z = z.astype(jnp.float32)
    b, s, _ = z.shape
    o1, o2, o3 = RWKV_DIM, 2 * RWKV_DIM, 3 * RWKV_DIM
    o4, o5 = o3 + W_LORA, o3 + W_LORA + A_LORA
    r, k, v = z[..., :o1], z[..., o1:o2], z[..., o2:o3]
    w_d, a_d, g_d = z[..., o3:o4], z[..., o4:o5], z[..., o5:]
    w_log = -jax.nn.softplus(-(w0 + jnp.tanh(w_d) @ w2)) - 0.5
    decay = jnp.exp(-jnp.exp(w_log))
    a = jax.nn.sigmoid(a0 + a_d @ a2)
    g = jax.nn.sigmoid(g_d) @ g2
    heads = lambda t: t.reshape(b, s, RWKV_HEADS, HEAD_DIM)
    kk = heads(k * k_k)
    kk = kk * lax.rsqrt(jnp.sum(kk * kk, axis=-1, keepdims=True) + 1e-12)
    k = k * (1.0 + (a - 1.0) * k_a)
    rh, kh, vh = heads(r), heads(k), heads(v)
    y = wkv7_scan(rh, heads(decay), kh, vh, kk, heads(a))
    mean = jnp.mean(y, axis=-1, keepdims=True)
    var = jnp.mean(jnp.square(y - mean), axis=-1, keepdims=True)
    y = ((y - mean) * lax.rsqrt(var + RWKV_GN_EPS)).reshape(b, s, RWKV_DIM) * ln_w + ln_b
    y = y + (jnp.sum(rh * kh * r_k, axis=-1, keepdims=True) * vh).reshape(b, s, RWKV_DIM)
    return y * g


def alibi_slopes(n_heads):
    return jnp.asarray(2.0 ** (-8.0 * np.arange(1, n_heads + 1) / n_heads), dtype=jnp.float32)


def dilated_window_attention(q, k, v, slopes, window, dilation):
    b, s, h, hd = q.shape
    d = dilation
    n_back = window // dilation
    span = d * Q_BLOCK
    s_pad = -(-s // span) * span
    L = s_pad // d
    nb = L // Q_BLOCK

    def to_blocks(t):
        t = jnp.pad(t.astype(jnp.float32), ((0, 0), (0, s_pad - s), (0, 0), (0, 0)))
        t = t.reshape(b, L, d, h, hd).transpose(0, 2, 1, 3, 4)
        return t.reshape(b * d, nb, Q_BLOCK, h, hd)

    def with_prev(t):
        prev = jnp.pad(t[:, :-1], ((0, 0), (1, 0), (0, 0), (0, 0), (0, 0)))
        return jnp.concatenate([prev, t], axis=2)

    qb = to_blocks(q)
    kc, vc = with_prev(to_blocks(k)), with_prev(to_blocks(v))
    scores = jnp.einsum('znqhd,znkhd->znhqk', qb, kc) * (HEAD_DIM ** -0.5)
    delta = (jnp.arange(Q_BLOCK)[:, None] + Q_BLOCK) - jnp.arange(2 * Q_BLOCK)[None, :]
    key_idx = jnp.arange(nb)[:, None, None] * Q_BLOCK + jnp.arange(2 * Q_BLOCK)[None, None, :] - Q_BLOCK
    valid = (delta >= 0)[None] & (delta <= n_back)[None] & (key_idx >= 0)
    alibi = -slopes[:, None, None] * (d * delta).astype(jnp.float32)[None]
    scores = jnp.where(valid[None, :, None], scores + alibi[None, None], -jnp.inf)
    lse = jax.nn.logsumexp(scores, axis=-1)
    probs = jnp.exp(scores - lse[..., None])
    out = jnp.einsum('znhqk,znkhd->znqhd', probs, vc)
    out = out.reshape(b, d, L, h, hd).transpose(0, 2, 1, 3, 4).reshape(b, s_pad, h, hd)[:, :s]
    lse = lse.transpose(0, 1, 3, 2).reshape(b, d, L, h).transpose(0, 2, 1, 3).reshape(b, s_pad, h)[:, :s]
    return out, lse


def dilated_mixture_attention(qkv, slopes):
    b, s, _ = qkv.shape
    qkv = qkv.reshape(b, s, 3, ATTN_HEADS, HEAD_DIM)
    q, k, v = qkv[:, :, 0], qkv[:, :, 1], qkv[:, :, 2]
    outs, lses = [], []
    for g, (window, dilation) in enumerate(ATTN_GROUPS):
        sl = slice(g * HEADS_PER_GROUP, (g + 1) * HEADS_PER_GROUP)
        o, l = dilated_window_attention(q[:, :, sl], k[:, :, sl], v[:, :, sl], slopes[sl], window, dilation)
        outs.append(o)
        lses.append(l)
    outs = jnp.stack(outs, axis=0)
    alpha = jax.nn.softmax(jnp.stack(lses, axis=0), axis=0)
    return jnp.sum(alpha[..., None] * outs, axis=0).reshape(b, s, ATTN_OUT_DIM)


def hierarchical_moe(h, w_router_group, w_router_expert, w_exp_gate, w_exp_up, w_exp_down):
    b, s, dm = h.shape
    ht = h.reshape(b * s, dm)
    grp_probs = jax.nn.softmax((ht @ w_router_group).astype(jnp.float32), axis=-1)
    grp_w, grp_idx = lax.top_k(grp_probs, 1)
    exp_logits = jnp.einsum('td,gde->tge', ht, w_router_expert).astype(jnp.float32)
    sel = jnp.take_along_axis(exp_logits, grp_idx[:, :, None], axis=1)[:, 0]
    top_v, top_i = lax.top_k(sel, TOP_K_EXPERT)
    top_w = jax.nn.softmax(top_v, axis=-1) * grp_w
    within = jnp.sum(jax.nn.one_hot(top_i, EXPERTS_PER_GROUP, dtype=jnp.float32) * top_w[..., None], axis=1)
    combine = jax.nn.one_hot(grp_idx[:, 0], N_EXPERT_GROUPS, dtype=jnp.float32)[:, :, None] * within[:, None, :]
    y = jnp.zeros((b * s, dm), jnp.float32)
    for g in range(N_EXPERT_GROUPS):
        hg = jnp.einsum('td,edf->tef', ht, w_exp_gate[g])
        hu = jnp.einsum('td,edf->tef', ht, w_exp_up[g])
        act = jax.nn.silu(hg) * hu * combine[:, g, :, None]
        y = y + jnp.einsum('tef,efd->td', act, w_exp_down[g])
    return y.reshape(b, s, dm)


def setup_inputs(seed: int = 0) -> dict:
    key = jax.random.key(seed)
    ks = jax.random.split(key, 28)
    f32 = jnp.float32
    nrm = lambda k, shape, scale: jax.random.normal(k, shape, f32) * scale
    gain = lambda k, shape: 1.0 + 0.05 * jax.random.normal(k, shape, f32)
    E, G, F = EXPERTS_PER_GROUP, N_EXPERT_GROUPS, D_FF_EXPERT
    return {
        "x": nrm(ks[0], (BATCH, SEQ, D_MODEL), 1.0),
        "p": nrm(ks[1], (DEPTH, BATCH, SEQ, PLE_DIM), 1.0),
        "norm_mix": gain(ks[2], (DEPTH, D_MODEL)),
        "w_in": nrm(ks[3], (DEPTH, D_MODEL, IN_COLS), D_MODEL ** -0.5),
        "rwkv_mu": jax.random.uniform(ks[4], (DEPTH, RWKV_COLS), f32),
        "rwkv_w0": jax.random.uniform(ks[5], (DEPTH, RWKV_DIM), f32, -6.0, 1.0),
        "rwkv_w2": nrm(ks[6], (DEPTH, W_LORA, RWKV_DIM), 0.5 * W_LORA ** -0.5),
        "rwkv_a0": nrm(ks[7], (DEPTH, RWKV_DIM), 0.5),
        "rwkv_a2": nrm(ks[8], (DEPTH, A_LORA, RWKV_DIM), 0.5 * A_LORA ** -0.5),
        "rwkv_g2": nrm(ks[9], (DEPTH, G_LORA, RWKV_DIM), G_LORA ** -0.5),
        "rwkv_k_k": 0.85 + nrm(ks[10], (DEPTH, RWKV_DIM), 0.05),
        "rwkv_k_a": 1.0 + nrm(ks[11], (DEPTH, RWKV_DIM), 0.05),
        "rwkv_r_k": nrm(ks[12], (DEPTH, RWKV_HEADS, HEAD_DIM), 0.1),
        "rwkv_ln_w": gain(ks[13], (DEPTH, RWKV_DIM)),
        "rwkv_ln_b": nrm(ks[14], (DEPTH, RWKV_DIM), 0.02),
        "w_proj_a": nrm(ks[15], (DEPTH, RWKV_DIM, D_MODEL), RWKV_DIM ** -0.5),
        "w_proj_b": nrm(ks[16], (DEPTH, ATTN_OUT_DIM, D_MODEL), ATTN_OUT_DIM ** -0.5),
        "w_out": nrm(ks[17], (DEPTH, D_MODEL, D_MODEL), D_MODEL ** -0.5),
        "norm_moe": gain(ks[18], (DEPTH, D_MODEL)),
        "w_router_group": nrm(ks[19], (DEPTH, D_MODEL, G), D_MODEL ** -0.5),
        "w_router_expert": nrm(ks[20], (DEPTH, G, D_MODEL, E), D_MODEL ** -0.5),
        "w_exp_gate": nrm(ks[21], (DEPTH, G, E, D_MODEL, F), D_MODEL ** -0.5),
        "w_exp_up": nrm(ks[22], (DEPTH, G, E, D_MODEL, F), D_MODEL ** -0.5),
        "w_exp_down": nrm(ks[23], (DEPTH, G, E, F, D_MODEL), F ** -0.5),
        "norm_ple": gain(ks[24], (DEPTH, D_MODEL)),
        "w_ple_gate": nrm(ks[25], (DEPTH, D_MODEL, D_MODEL), D_MODEL ** -0.5),
        "w_ple_proj": nrm(ks[26], (DEPTH, PLE_DIM, D_MODEL), PLE_DIM ** -0.5),
        "norm_final": gain(ks[27], (D_MODEL,)),
    }


def reference(x, p, norm_mix, w_in, rwkv_mu, rwkv_w0, rwkv_w2, rwkv_a0, rwkv_a2, rwkv_g2,
              rwkv_k_k, rwkv_k_a, rwkv_r_k, rwkv_ln_w, rwkv_ln_b, w_proj_a, w_proj_b, w_out,
              norm_moe, w_router_group, w_router_expert, w_exp_gate, w_exp_up, w_exp_down,
              norm_ple, w_ple_gate, w_ple_proj, norm_final):
    slopes = alibi_slopes(ATTN_HEADS)
    b, s, _ = x.shape
    x = x.astype(jnp.float32)
    for i in range(DEPTH):
        h = rmsnorm(x, norm_mix[i])
        proj = h @ w_in[i]
        z_rwkv = token_shift(proj[..., :RWKV_COLS], rwkv_mu[i])
        qkv = proj[..., RWKV_COLS:RWKV_COLS + ATTN_COLS]
        gates = jax.nn.sigmoid(proj[..., RWKV_COLS + ATTN_COLS:].astype(jnp.float32))
        gates = gates.reshape(b, s, N_BRANCHES, D_MODEL)
        y_a = rwkv7_time_mix(z_rwkv, rwkv_w0[i], rwkv_w2[i], rwkv_a0[i], rwkv_a2[i], rwkv_g2[i],
                             rwkv_k_k[i], rwkv_k_a[i], rwkv_r_k[i], rwkv_ln_w[i], rwkv_ln_b[i])
        y_b = dilated_mixture_attention(qkv, slopes)
        merged = gates[:, :, 0] * (y_a @ w_proj_a[i]) + gates[:, :, 1] * (y_b @ w_proj_b[i])
        x = x + merged @ w_out[i]
        x = x + hierarchical_moe(rmsnorm(x, norm_moe[i]), w_router_group[i], w_router_expert[i],
                                 w_exp_gate[i], w_exp_up[i], w_exp_down[i])
        ple_gate = jax.nn.sigmoid(rmsnorm(x, norm_ple[i]) @ w_ple_gate[i])
        x = x + ple_gate * (p[i] @ w_ple_proj[i])
    return rmsnorm(x, norm_final)
```

```cpp
#define MK_N_LAUNCHES 16
#include <hip/hip_runtime.h>
#include <cstdio>
#include <cstdint>

#define LAS __attribute__((address_space(3)))
#define GAS __attribute__((address_space(1)))
typedef unsigned short bf16_t;
typedef short bf16x8 __attribute__((ext_vector_type(8)));
typedef float f32x4 __attribute__((ext_vector_type(4)));
typedef float f32x16 __attribute__((ext_vector_type(16)));
typedef unsigned u32x4 __attribute__((ext_vector_type(4)));
typedef unsigned u32x2 __attribute__((ext_vector_type(2)));
typedef GAS unsigned gu32;

#ifndef MK_N_LAUNCHES
#define MK_N_LAUNCHES 1
#endif

constexpr int T_TOK = 16384, SEQ = 8192, DM = 1024, RW_COLS = 1792, IN_COLS = 8448, NHEAD_A = 24;
constexpr int NCHUNK = T_TOK / 64;
constexpr float NORM_EPS = 1e-6f, GN_EPS = 64e-5f;
constexpr float LOG2E = 1.4426950408889634f;

constexpr size_t MiB = 1u << 20;
constexpr size_t WS_CTL = 0, CTL_ZERO_BYTES = 1 * MiB;
constexpr size_t WS_RSTD0 = 1 * MiB, WS_RSTD1 = WS_RSTD0 + 65536, WS_RSTD2 = WS_RSTD1 + 65536, WS_RSS3 = WS_RSTD2 + 65536;
constexpr size_t WS_RK = 1 * MiB + 512 * 1024;
constexpr size_t WS_W2T = 2 * MiB, WS_A2T = WS_W2T + 65536, WS_G2T = WS_A2T + 65536;
constexpr size_t WS_WR = 2 * MiB + 512 * 1024;
constexpr size_t WS_LSE = 3 * MiB;
constexpr size_t WS_A1 = 6 * MiB;
constexpr size_t WS_A2 = 23 * MiB;
constexpr size_t WS_RW = 55 * MiB;
constexpr size_t WS_Q = 111 * MiB, WS_K = 159 * MiB, WS_V = 207 * MiB;
constexpr size_t WS_TMP = 55 * MiB, WS_MERGED = 87 * MiB, WS_X1 = 119 * MiB, WS_LIST = 151 * MiB, WS_LISTW = 153 * MiB;
constexpr size_t WS_MOEOUT = 55 * MiB;
constexpr size_t WS_PF = 159 * MiB, WS_GF = 175 * MiB, WS_QF = 191 * MiB, WS_YF = 207 * MiB;
constexpr size_t WS_YA = 159 * MiB;
constexpr size_t WS_HID = 159 * MiB;
constexpr size_t WS_X2 = 175 * MiB;
constexpr size_t WS_WDT = 223 * MiB;
constexpr size_t WS_WAT = 239 * MiB, WS_WBT = 240 * MiB, WS_WOT = 241 * MiB, WS_WPGT = 243 * MiB, WS_WPPT = 245 * MiB, WS_PB = 246 * MiB;
constexpr size_t WS_END = 256 * MiB;
constexpr int CW_TMO = 0, CW_CNT = 64  , CW_BAR = 4096;

constexpr int RING_BYTES = 131072, MISC_OFF = RING_BYTES + 320, LDS_BYTES = 163840;

#define RLX_AGENT __ATOMIC_RELAXED, __HIP_MEMORY_SCOPE_AGENT
__device__ __forceinline__ unsigned f2bf(float f) { unsigned u = __builtin_bit_cast(unsigned, f); return (u + 0x7fffu + ((u >> 16) & 1u)) >> 16; }
__device__ __forceinline__ unsigned pk2(float lo, float hi) { return f2bf(lo) | (f2bf(hi) << 16); }
__device__ __forceinline__ float bf2f(unsigned h) { return __builtin_bit_cast(float, h << 16); }
__device__ __forceinline__ float bflo(unsigned w) { return __builtin_bit_cast(float, w << 16); }
__device__ __forceinline__ float bfhi(unsigned w) { return __builtin_bit_cast(float, w & 0xffff0000u); }
__device__ __forceinline__ void unpack8(u32x4 w, float* f) { f[0] = bflo(w.x); f[1] = bfhi(w.x); f[2] = bflo(w.y); f[3] = bfhi(w.y); f[4] = bflo(w.z); f[5] = bfhi(w.z); f[6] = bflo(w.w); f[7] = bfhi(w.w); }
__device__ __forceinline__ u32x4 pack8(const float* f) { u32x4 w; w.x = pk2(f[0], f[1]); w.y = pk2(f[2], f[3]); w.z = pk2(f[4], f[5]); w.w = pk2(f[6], f[7]); return w; }
__device__ __forceinline__ float sigmoidf_(float x) { return 1.0f / (1.0f + __expf(-x)); }
__device__ __forceinline__ float wave_sum(float v) {
#pragma unroll
    for (int o = 1; o < 64; o <<= 1) v += __shfl_xor(v, o);
    return v;
}
__device__ __forceinline__ int crow(int r, int hi) { return (r & 3) + 8 * (r >> 2) + 4 * hi; }
__device__ __forceinline__ int otid() { int t = threadIdx.x; asm volatile("" : "+v"(t)); return t; }
#define LDS_WAIT() asm volatile("s_waitcnt lgkmcnt(0)" ::: "memory")
#define VM_WAIT() asm volatile("s_waitcnt vmcnt(0)" ::: "memory")

namespace pg8 {
constexpr int BM = 256, BK = 64, HALF = 128, HTB = HALF * BK * 2, STAGE_BYTES = 8 * HTB, NXCD = 8, WGM = 8;
__host__ __device__ __forceinline__ int lds_byte(int r, int c) { const int st = (r >> 4) * 2 + (c >> 5), rr = r & 15, cc = c & 31, ob = rr * 64 + cc * 2; return st * 1024 + (ob ^ (((ob >> 9) & 1) << 5)); }
__host__ __device__ __forceinline__ void stage_rc(int b, int& R, int& C) { const int st = b / 1024, sb = b % 1024, swz = sb ^ (((sb >> 9) & 1) << 5); R = (st >> 1) * 16 + swz / 64; C = (st & 1) * 32 + (swz % 64) / 2; }
__host__ __device__ __forceinline__ int perm32(int rho) { const int n = rho >> 4, i = rho & 15; return 8 * (i >> 2) + 4 * n + (i & 3); }

struct Unit { int pm, pn, e, nrows, rbase; };

struct StaticOrder {
    int nM, nN, nwg, G, c, K;
    __device__ void init(int M, int N, int K_, int G_, int c_) { nM = M / BM; nN = N / BM; nwg = nM * nN; G = G_; c = c_; K = K_; }
    __device__ bool next(int i, Unit& u) const {
        const long L = (long)i * G + c; if (L >= nwg) return false;
        int wgid = (int)L; { const int q = nwg / NXCD, r = nwg % NXCD, xcd = wgid % NXCD, off = wgid / NXCD; wgid = (xcd < r ? xcd * (q + 1) : r * (q + 1) + (xcd - r) * q) + off; }
        const int nig = WGM * nN, gid = wgid / nig, fm = gid * WGM, gsz = (nM - fm) < WGM ? (nM - fm) : WGM;
        u.pm = fm + ((wgid % nig) % gsz); u.pn = (wgid % nig) / gsz; u.e = 0; u.nrows = 256; u.rbase = u.pm * 256; return true;
    }
    static constexpr bool GATHER = false;
    __device__ __forceinline__ unsigned arow(const Unit& u, int r) const { return (unsigned)(u.pm * BM + r); }
    __device__ __forceinline__ unsigned arow0(const Unit& u) const { return (unsigned)(u.pm * BM); }
    __device__ __forceinline__ size_t boff(const Unit& u) const { return (size_t)u.pn * BM * K; }
};

constexpr int AOFF_LDS = STAGE_BYTES + 2048;
template <class Epi, class Sched>
__device__ __forceinline__ void gemm_phase(LAS unsigned char* lds, const bf16_t* Ap, const bf16_t* Btp, const int K, const Sched& S, const Epi& E) {
    constexpr bool GA = Sched::GATHER;
    const int tid = otid(), wid = __builtin_amdgcn_readfirstlane(tid >> 6), lane = tid & 63, wr = wid >> 2, wc = wid & 3, fr = lane & 15, fq = lane >> 4;
    const int nt = K / BK;
    unsigned voffA[2], voffB[2];
#pragma unroll
    for (int i = 0; i < 2; ++i) { int R, C; stage_rc(tid * 16 + i * 8192, R, C); const int Rb = Epi::PERM ? ((R & ~31) + perm32(R & 31)) : R; voffA[i] = (unsigned)(R * K + C) * 2u; voffB[i] = (unsigned)(Rb * K + C) * 2u; }
    const size_t kstep = (size_t)(BK * 2);
    const size_t hstep = (size_t)HALF * K * 2;
    const unsigned ldsw = (unsigned)wid * 1024u;
    const int aoff = lds_byte(wr * 64 + fr, fq * 8), boff = lds_byte(wc * 32 + fr, fq * 8);
#define PG8_SA(b, h) (((b) * 2 + (h)) * HTB)
#define PG8_SB(b, h) ((4 + (b) * 2 + (h)) * HTB)
#define PG8_STAGE(bufoff, gbase, voff) do { _Pragma("unroll") for (int _i = 0; _i < 2; ++_i) \
        __builtin_amdgcn_global_load_lds((const unsigned*)((const char*)(gbase) + (voff)[_i]), (LAS unsigned*)(lds + (bufoff) + ldsw + _i * 8192), 16, 0, 0); } while (0)
#define PG8_STAGE_A(bufoff, h, slot, ubase, kb) do { if constexpr (GA) { const u32x2 _o = *(const LAS u32x2*)(lds + AOFF_LDS + (slot) * 8192 + tid * 16 + (h) * 8); unsigned _v[2] = {_o.x, _o.y}; PG8_STAGE(bufoff, (const char*)Ap + (kb), _v); } \
        else { PG8_STAGE(bufoff, (ubase) + (h) * hstep + (kb), voffA); } } while (0)
#define PG8_AOFF_STORE(slot, U) do { if constexpr (GA) { int _t = otid(); unsigned _q[2][2]; _Pragma("unroll") for (int _h = 0; _h < 2; ++_h) _Pragma("unroll") for (int _i = 0; _i < 2; ++_i) { int _R, _C; stage_rc(_t * 16 + _i * 8192, _R, _C); \
        _q[_h][_i] = S.arow(U, _h * HALF + _R) * (unsigned)(K * 2) + (unsigned)(_C * 2); } *(LAS u32x4*)(lds + AOFF_LDS + (slot) * 8192 + _t * 16) = (u32x4){_q[0][0], _q[0][1], _q[1][0], _q[1][1]}; } } while (0)
#define PG8_LDA(dst, b, h) do { _Pragma("unroll") for (int m = 0; m < 4; ++m) _Pragma("unroll") for (int k = 0; k < 2; ++k) dst[m][k] = *(const LAS bf16x8*)(lds + PG8_SA(b, h) + aoff + m * 2048 + k * 1024); } while (0)
#define PG8_LDB(dst, b, h) do { _Pragma("unroll") for (int n = 0; n < 2; ++n) _Pragma("unroll") for (int k = 0; k < 2; ++k) dst[n][k] = *(const LAS bf16x8*)(lds + PG8_SB(b, h) + boff + n * 2048 + k * 1024); } while (0)
#define PG8_MMA(ai, bj, At, Bt) do { __builtin_amdgcn_s_setprio(1); _Pragma("unroll") for (int m = 0; m < 4; ++m) _Pragma("unroll") for (int n = 0; n < 2; ++n) _Pragma("unroll") for (int k = 0; k < 2; ++k) \
        acc[ai][bj][m][n] = __builtin_amdgcn_mfma_f32_16x16x32_bf16(Bt[n][k], At[m][k], acc[ai][bj][m][n], 0, 0, 0); __builtin_amdgcn_s_setprio(0); } while (0)
#define PG8_WAIT_V(n) asm volatile("s_waitcnt vmcnt(" #n ")" ::: "memory")
#define PG8_WAIT_L(n) asm volatile("s_waitcnt lgkmcnt(" #n ")" ::: "memory")
#define PG8_BAR __builtin_amdgcn_s_barrier()
#define PG8_SCHED __builtin_amdgcn_sched_barrier(0)
    Unit cur, nxt; int ui = 0;
    if (!S.next(0, cur)) return;
    PG8_AOFF_STORE(0, cur);
    if constexpr (GA) { LDS_WAIT(); }
    f32x4 acc[2][2][4][2];
#pragma unroll
    for (int a = 0; a < 2; ++a)
#pragma unroll
        for (int b = 0; b < 2; ++b)
#pragma unroll
            for (int m = 0; m < 4; ++m)
#pragma unroll
                for (int n = 0; n < 2; ++n) acc[a][b][m][n] = (f32x4){0.f, 0.f, 0.f, 0.f};
    bf16x8 At[4][2], B0[2][2], B1[2][2];
    const char* cA = (const char*)Ap + (size_t)S.arow0(cur) * K * 2;
    const char* cB = (const char*)(Btp + S.boff(cur));
    int cs = 0;
    PG8_STAGE(PG8_SB(0, 0), cB, voffB); PG8_STAGE(PG8_SB(0, 1), cB + hstep, voffB); PG8_STAGE_A(PG8_SA(0, 0), 0, cs, cA, 0); PG8_STAGE_A(PG8_SA(0, 1), 1, cs, cA, 0);
    if (wr == 1) PG8_BAR;
    PG8_WAIT_V(2); PG8_BAR;
    PG8_STAGE(PG8_SB(1, 0), cB + kstep, voffB); PG8_STAGE_A(PG8_SA(1, 0), 0, cs, cA, kstep); PG8_STAGE(PG8_SB(1, 1), cB + hstep + kstep, voffB);
    PG8_WAIT_V(6); PG8_BAR;
    for (;;) {
        const bool has_next = S.next(ui + 1, nxt);
        const char* nA = has_next ? (const char*)Ap + (size_t)S.arow0(nxt) * K * 2 : cA;
        const char* nB = has_next ? (const char*)(Btp + S.boff(nxt)) : cB;
        if (has_next) PG8_AOFF_STORE(cs ^ 1, nxt);
        for (int t = 0; t < nt; t += 2) {
            const bool last = (t == nt - 2);
            const size_t k1 = (size_t)(t + 1) * kstep;
            const size_t k2 = last ? (size_t)0 : (size_t)(t + 2) * kstep, k3 = k2 + kstep;
            const char* a2 = last ? nA : cA;
            const char* b2 = last ? nB : cB + (size_t)(t + 2) * kstep; const char* b3 = b2 + kstep;
            const int s2 = (last && has_next) ? (cs ^ 1) : cs;
            PG8_LDB(B0, 0, 0); PG8_LDB(B1, 0, 1); PG8_SCHED; PG8_LDA(At, 0, 0); PG8_STAGE_A(PG8_SA(1, 1), 1, cs, cA, k1);
            PG8_WAIT_V(8); PG8_WAIT_L(0); PG8_BAR; PG8_MMA(0, 0, At, B0); PG8_MMA(0, 1, At, B1); PG8_BAR; PG8_SCHED;
            PG8_LDA(At, 0, 1); PG8_STAGE(PG8_SB(0, 0), b2, voffB); PG8_STAGE(PG8_SB(0, 1), b2 + hstep, voffB); PG8_STAGE_A(PG8_SA(0, 0), 0, s2, a2, k2);
            PG8_WAIT_V(8); PG8_WAIT_L(0); PG8_BAR; PG8_MMA(1, 0, At, B0); PG8_MMA(1, 1, At, B1); PG8_BAR; PG8_SCHED;
            PG8_LDB(B0, 1, 0); PG8_LDB(B1, 1, 1); PG8_SCHED; PG8_LDA(At, 1, 0); PG8_STAGE_A(PG8_SA(0, 1), 1, s2, a2, k2);
            PG8_WAIT_V(8); PG8_WAIT_L(0); PG8_BAR; PG8_MMA(0, 0, At, B0); PG8_MMA(0, 1, At, B1); PG8_BAR; PG8_SCHED;
            PG8_LDA(At, 1, 1); PG8_STAGE(PG8_SB(1, 0), b3, voffB); PG8_STAGE(PG8_SB(1, 1), b3 + hstep, voffB); PG8_STAGE_A(PG8_SA(1, 0), 0, s2, a2, k3);
            PG8_WAIT_V(8); PG8_WAIT_L(0); PG8_BAR; PG8_MMA(1, 0, At, B0); PG8_MMA(1, 1, At, B1); PG8_BAR; PG8_SCHED;
        }
        if (wr == 0) PG8_BAR;
        { const int t2 = otid(); E(acc, cur, wr, wc, t2 & 15, (t2 >> 4) & 3); }
        if (!has_next) break;
#pragma unroll
        for (int a = 0; a < 2; ++a)
#pragma unroll
            for (int b = 0; b < 2; ++b)
#pragma unroll
                for (int m = 0; m < 4; ++m)
#pragma unroll
                    for (int n = 0; n < 2; ++n) acc[a][b][m][n] = (f32x4){0.f, 0.f, 0.f, 0.f};
        cur = nxt; cA = nA; cB = nB; ++ui; cs ^= 1;
        if (wr == 1) PG8_BAR;
    }
    PG8_WAIT_V(0);
    PG8_BAR;
#undef PG8_SA
#undef PG8_SB
#undef PG8_STAGE
#undef PG8_STAGE_A
#undef PG8_AOFF_STORE
#undef PG8_LDA
#undef PG8_LDB
#undef PG8_MMA
#undef PG8_WAIT_V
#undef PG8_WAIT_L
#undef PG8_BAR
#undef PG8_SCHED
}
}

#define XB_TMO      128
#define XB_XCNT(j)  (256  + 64 * (j))
#define XB_XSUB(j)  (1280 + 64 * (j))
#define XB_XGEN(j)  (2304 + 64 * (j))
#define XB_TOP      3328
#define XB_TOPGEN   3392
#define XCD_BAR_WORDS 3456
#define XB_SPIN_CAP (1u << 18)
__device__ __forceinline__ unsigned xb_ld(unsigned* p)              { return __hip_atomic_load(p, __ATOMIC_RELAXED, __HIP_MEMORY_SCOPE_AGENT); }
__device__ __forceinline__ unsigned xb_add(unsigned* p, unsigned v) { return __hip_atomic_fetch_add(p, v, __ATOMIC_RELAXED, __HIP_MEMORY_SCOPE_AGENT); }
__device__ __forceinline__ unsigned xb_xcc_id() { return (unsigned)__builtin_amdgcn_s_getreg((3 << 11) | 20) & 0xFu; }
#define XB_SPIN(cond, bar) do { unsigned _sp = 0; while (cond) { __builtin_amdgcn_s_sleep(1); \
    if ((++_sp & 255u) == 0u) { if (xb_ld(&(bar)[XB_TMO])) break; if (_sp > XB_SPIN_CAP) { atomicAdd(&(bar)[XB_TMO], 1u); break; } } } } while (0)
struct XcdBarrier { unsigned* bar; unsigned x; volatile LAS unsigned* st; };
__device__ __forceinline__ XcdBarrier xcd_barrier_post(unsigned* bar, volatile LAS unsigned* st) {
    XcdBarrier b; b.bar = bar; b.x = xb_xcc_id(); b.st = st;
    if (threadIdx.x == 0) (void)xb_add(&bar[XB_XCNT(b.x)], 1u);
    return b;
}
__device__ __forceinline__ void xcd_barrier_complete(unsigned* bar, unsigned x, unsigned& nloc, unsigned& nx) {
    const unsigned G = gridDim.x * gridDim.y * gridDim.z;
    unsigned sum, cnt, mine, sp = 0u;
    for (;;) {
        sum = 0u; cnt = 0u; mine = 0u;
#pragma unroll
        for (unsigned j = 0; j < 16; ++j) { const unsigned c = xb_ld(&bar[XB_XCNT(j)]); sum += c; cnt += (c > 0u) ? 1u : 0u; mine = (j == x) ? c : mine; }
        if (sum == G) break;
        __builtin_amdgcn_s_sleep(1);
        if ((++sp & 255u) == 0u) { if (xb_ld(&bar[XB_TMO])) break; if (sp > XB_SPIN_CAP) { atomicAdd(&bar[XB_TMO], 1u); break; } }
    }
    nloc = mine > 0u ? mine : 1u; nx = cnt > 0u ? cnt : 1u;
}
__device__ __forceinline__ void xcd_barrier(const XcdBarrier& b) {
    asm volatile("s_waitcnt vmcnt(0)" ::: "memory");
    __syncthreads();
    if (threadIdx.x == 0) {
        unsigned* bar = b.bar;
        __builtin_amdgcn_s_waitcnt(0);
        unsigned nloc = b.st[0], nx = b.st[1];
        if (nloc == 0u) { xcd_barrier_complete(bar, b.x, nloc, nx); b.st[0] = nloc; b.st[1] = nx; }
        const unsigned old = xb_add(&bar[XB_XSUB(b.x)], 1u);
        const unsigned gen = old / nloc;
        if (old + 1u == (gen + 1u) * nloc) {
            __builtin_amdgcn_fence(__ATOMIC_RELEASE, "agent");
            asm volatile("s_waitcnt vmcnt(0)" ::: "memory");
            const unsigned og = xb_add(&bar[XB_TOP], 1u);
            const unsigned tg = og / nx;
            if (og + 1u == (tg + 1u) * nx) xb_add(&bar[XB_TOPGEN], 1u);
            else XB_SPIN(xb_ld(&bar[XB_TOPGEN]) == tg, bar);
            __builtin_amdgcn_fence(__ATOMIC_ACQUIRE, "agent");
            xb_add(&bar[XB_XGEN(b.x)], 1u);
            asm volatile("s_waitcnt vmcnt(0)" ::: "memory");
        } else {
            XB_SPIN(xb_ld(&bar[XB_XGEN(b.x)]) == gen, bar);
            __builtin_amdgcn_fence(__ATOMIC_ACQUIRE, "agent");
            asm volatile("s_waitcnt vmcnt(0)" ::: "memory");
        }
    }
    __syncthreads();
}

typedef const float* cfp_t;
struct Frame {
    LAS unsigned char* lds;
    gu32* ctl;
    int wave, vcu, G;
    unsigned char* ws;
    const __attribute__((address_space(4))) cfp_t* in;
    float* out;
};
constexpr int NWAVES = 8;

__device__ __forceinline__ void transpose_item(const float* W, int ldw, int k0, int n0, bf16_t* WT, int kp, int dst_row0, const float* gain, LAS float* scr, int lane) {
#pragma unroll 8
    for (int i = 0; i < 32; ++i) { const int kk = 2 * i + (lane >> 5); float v = W[(size_t)(k0 + kk) * ldw + n0 + (lane & 31)]; if (gain) v *= gain[k0 + kk]; scr[kk * 33 + (lane & 31)] = v; }
    LDS_WAIT(); asm volatile("" ::: "memory");
    const int c = lane & 7;
#pragma unroll
    for (int j = 0; j < 4; ++j) { const int n = (lane >> 3) + 8 * j; const LAS float* s = scr + (8 * c) * 33 + n;
        u32x4 o; o.x = pk2(s[0 * 33], s[1 * 33]); o.y = pk2(s[2 * 33], s[3 * 33]); o.z = pk2(s[4 * 33], s[5 * 33]); o.w = pk2(s[6 * 33], s[7 * 33]);
        *(GAS u32x4*)(WT + (size_t)(dst_row0 + n) * kp + k0 + 8 * c) = o; }
    LDS_WAIT(); asm volatile("" ::: "memory");
}
__device__ __forceinline__ void transpose_job(const float* W, int K, int N, bf16_t* WT, const float* gain, LAS float* scr, int lane, int item) {
    const int nblk = N / 32, kb = item / nblk, nb = item % nblk;
    transpose_item(W, N, 64 * kb, 32 * nb, WT, K, 32 * nb, gain, scr, lane);
}

constexpr int NJOBS = 12;
__device__ __forceinline__ int job_items(int j) {
    switch (j) { case 0: return 16 * 264; case 1: return 16; case 2: return 16; case 3: return 32; case 4: return 256; case 5: return 256; case 6: return 512; case 7: return 512; case 8: return 128;
                 case 9: return 4096; case 10: return 4096; default: return 4096; }
}
__device__ __forceinline__ void conv_item(Frame& F, int j, int it, LAS float* scr) {
    unsigned char* ws = F.ws; const int lane = otid() & 63;
    switch (j) {
    case 0: transpose_job(F.in[3], 1024, IN_COLS, (bf16_t*)(ws + WS_A1), F.in[2], scr, lane, it); break;
    case 1: transpose_job(F.in[6], 64, 512, (bf16_t*)(ws + WS_W2T), nullptr, scr, lane, it); break;
    case 2: transpose_job(F.in[8], 64, 512, (bf16_t*)(ws + WS_A2T), nullptr, scr, lane, it); break;
    case 3: transpose_job(F.in[9], 128, 512, (bf16_t*)(ws + WS_G2T), nullptr, scr, lane, it); break;
    case 4: transpose_job(F.in[15], 512, 1024, (bf16_t*)(ws + WS_WAT), nullptr, scr, lane, it); break;
    case 5: transpose_job(F.in[16], 512, 1024, (bf16_t*)(ws + WS_WBT), nullptr, scr, lane, it); break;
    case 6: transpose_job(F.in[17], 1024, 1024, (bf16_t*)(ws + WS_WOT), nullptr, scr, lane, it); break;
    case 7: transpose_job(F.in[25], 1024, 1024, (bf16_t*)(ws + WS_WPGT), F.in[24], scr, lane, it); break;
    case 8: transpose_job(F.in[26], 256, 1024, (bf16_t*)(ws + WS_WPPT), nullptr, scr, lane, it); break;
    case 9: case 10: {
        const int e = it >> 7, r = it & 127, kb = r >> 3, nb = r & 7, f0 = 32 * nb;
        const float* W = F.in[j == 9 ? 21 : 22] + (size_t)e * 1024 * 256;
        bf16_t* WT = (bf16_t*)(ws + WS_A2) + (size_t)e * 512 * 1024;
        transpose_item(W, 256, 64 * kb, f0, WT, 1024, (f0 >> 7) * 256 + (j == 10 ? 128 : 0) + (f0 & 127), F.in[18], scr, lane); break; }
    default: {
        const int e = it >> 7, r = it & 127, kb = r >> 5, nb = r & 31;
        transpose_item(F.in[23] + (size_t)e * 256 * 1024, 1024, 64 * kb, 32 * nb, (bf16_t*)(ws + WS_WDT) + (size_t)e * 1024 * 256, 256, 32 * nb, nullptr, scr, lane); break; }
    }
}
__device__ __forceinline__ void conv_jobs(Frame& F, int jlo, int jhi, int gw, int ngw) {
    if (gw < 0) return;
    LAS float* scr = (LAS float*)(F.lds + F.wave * 16384);
    int base = 0;
    for (int j = jlo; j < jhi; ++j) {
        const int n = job_items(j);
        int it = ((gw - base) % ngw + ngw) % ngw;
        for (; it < n; it += ngw) conv_item(F, j, it, scr);
        base += n;
    }
}
__device__ __forceinline__ void row_to_bf16_rstd(const float* xrow, bf16_t* orow, float* rstd, int lane) {
    const GAS f32x4* xr = (const GAS f32x4*)xrow + lane;
    f32x4 v[4]; float s = 0.f;
#pragma unroll
    for (int j = 0; j < 4; ++j) { v[j] = xr[64 * j]; s += (v[j].x * v[j].x + v[j].y * v[j].y) + (v[j].z * v[j].z + v[j].w * v[j].w); }
    s = wave_sum(s);
    if (lane == 0) *rstd = 1.0f / sqrtf(s * (1.0f / 1024.0f) + NORM_EPS);
    GAS u32x2* o8 = (GAS u32x2*)orow + lane;
#pragma unroll
    for (int j = 0; j < 4; ++j) { u32x2 w; w.x = pk2(v[j].x, v[j].y); w.y = pk2(v[j].z, v[j].w); o8[64 * j] = w; }
}

using pg8::Unit;
struct EpiStoreBf16 {
    static constexpr bool PERM = true;
    bf16_t* O; int ldc;
    __device__ __forceinline__ void operator()(const f32x4 (&acc)[2][2][4][2], const Unit& u, int wr, int wc, int fr, int fq) const {
        asm volatile("" : "+v"(fr), "+v"(fq));
#pragma unroll
        for (int ai = 0; ai < 2; ++ai)
#pragma unroll
            for (int m = 0; m < 4; ++m) { const int row = u.pm * 256 + ai * 128 + wr * 64 + m * 16 + fr;
#pragma unroll
                for (int bj = 0; bj < 2; ++bj) { const int c0 = u.pn * 256 + bj * 128 + wc * 32 + 8 * fq; const f32x4 v0 = acc[ai][bj][m][0], v1 = acc[ai][bj][m][1];
                    u32x4 w; w.x = pk2(v0[0], v0[1]); w.y = pk2(v0[2], v0[3]); w.z = pk2(v1[0], v1[1]); w.w = pk2(v1[2], v1[3]);
                    *(u32x4*)(O + (size_t)row * ldc + c0) = w; } }
    }
};
struct EpiPleGate {
    static constexpr bool PERM = true;
    const bf16_t* X2; const bf16_t* PP; const float* rstd2; float* out; float* rss3;
    __device__ __forceinline__ void operator()(const f32x4 (&acc)[2][2][4][2], const Unit& u, int wr, int wc, int fr, int fq) const {
        asm volatile("" : "+v"(fr), "+v"(fq));
#pragma unroll
        for (int ai = 0; ai < 2; ++ai)
#pragma unroll
            for (int m = 0; m < 4; ++m) { const int row = u.pm * 256 + ai * 128 + wr * 64 + m * 16 + fr; const float rs = rstd2[row]; float ss = 0.f;
#pragma unroll
                for (int bj = 0; bj < 2; ++bj) { const int c0 = u.pn * 256 + bj * 128 + wc * 32 + 8 * fq;
                    float x2[8], pp[8], o[8]; unpack8(*(const u32x4*)(X2 + (size_t)row * 1024 + c0), x2); unpack8(*(const u32x4*)(PP + (size_t)row * 1024 + c0), pp);
#pragma unroll
                    for (int j = 0; j < 8; ++j) { const float a = acc[ai][bj][m][j >> 2][j & 3]; o[j] = x2[j] + sigmoidf_(rs * a) * pp[j]; ss += o[j] * o[j]; }
                    float* op = out + (size_t)row * 1024 + c0; *(f32x4*)op = (f32x4){o[0], o[1], o[2], o[3]}; *(f32x4*)(op + 4) = (f32x4){o[4], o[5], o[6], o[7]}; }
                ss += __shfl_xor(ss, 16); ss += __shfl_xor(ss, 32);
                if (fq == 0) atomicAdd(rss3 + row, ss); }
    }
};

__device__ __forceinline__ void x2prep_phase(Frame& F, int mode) {
    const int gw = F.vcu * NWAVES + F.wave, NGW = F.G * NWAVES, lane = otid() & 63;
    bf16_t* X2 = (bf16_t*)(F.ws + WS_X2); float* rstd2 = (float*)(F.ws + WS_RSTD2);
    const bf16_t* X1 = (const bf16_t*)(F.ws + WS_X1); const bf16_t* MO = (const bf16_t*)(F.ws + WS_MOEOUT);
    for (int m = gw; m < T_TOK; m += NGW) {
        if (mode == 0) { row_to_bf16_rstd(F.in[0] + (size_t)m * 1024, X2 + (size_t)m * 1024, rstd2 + m, lane); continue; }
        float v[16]; unpack8(*(const u32x4*)(X1 + (size_t)m * 1024 + lane * 8), v); unpack8(*(const u32x4*)(X1 + (size_t)m * 1024 + 512 + lane * 8), v + 8);
        if (mode == 2) {
#pragma unroll
            for (int s = 0; s < 2; ++s) { float a[16]; const bf16_t* mp = MO + ((size_t)s * T_TOK + m) * 1024;
                unpack8(*(const u32x4*)(mp + lane * 8), a); unpack8(*(const u32x4*)(mp + 512 + lane * 8), a + 8);
#pragma unroll
                for (int j = 0; j < 16; ++j) v[j] += a[j]; }
        }
        float s = 0.f;
#pragma unroll
        for (int j = 0; j < 16; ++j) s += v[j] * v[j];
        s = wave_sum(s);
        if (lane == 0) rstd2[m] = 1.0f / sqrtf(s * (1.0f / 1024.0f) + NORM_EPS);
        *(u32x4*)(X2 + (size_t)m * 1024 + lane * 8) = pack8(v); *(u32x4*)(X2 + (size_t)m * 1024 + 512 + lane * 8) = pack8(v + 8);
    }
}
__device__ __forceinline__ void pb_phase(Frame& F, int gw, int ngw) {
    if (gw < 0) return;
    bf16_t* PB = (bf16_t*)(F.ws + WS_PB); const float* p = F.in[1]; const int lane = otid() & 63;
    for (int m = gw; m < T_TOK; m += ngw) { const f32x4 v = *((const f32x4*)(p + (size_t)m * 256) + lane); u32x2 w; w.x = pk2(v.x, v.y); w.y = pk2(v.z, v.w); *((u32x2*)(PB + (size_t)m * 256) + lane) = w; }
}
__device__ __forceinline__ void final_phase(Frame& F) {
    const int gw = F.vcu * NWAVES + F.wave, NGW = F.G * NWAVES, lane = otid() & 63;
    const float* rss3 = (const float*)(F.ws + WS_RSS3); const float* g = F.in[27];
    for (int m = gw; m < T_TOK; m += NGW) {
        const float rs = 1.0f / sqrtf(rss3[m] * (1.0f / 1024.0f) + NORM_EPS);
        f32x4* o = (f32x4*)(F.out + (size_t)m * 1024) + lane;
#pragma unroll
        for (int j = 0; j < 4; ++j) { f32x4 v = o[64 * j]; const f32x4 gg = *((const f32x4*)g + lane + 64 * j); v = v * rs * gg; o[64 * j] = v; }
    }
}

constexpr float QSCALE = 0.125f * LOG2E;
struct EpiG1 {
    static constexpr bool PERM = true;
    const float* rstd0; bf16_t* RW; bf16_t* QKV; bf16_t* GATES;
    __device__ __forceinline__ void operator()(const f32x4 (&acc)[2][2][4][2], const Unit& u, int wr, int wc, int fr, int fq) const {
        asm volatile("" : "+v"(fr), "+v"(fq));
#pragma unroll
        for (int ai = 0; ai < 2; ++ai)
#pragma unroll
            for (int m = 0; m < 4; ++m) { const int row = u.pm * 256 + ai * 128 + wr * 64 + m * 16 + fr; const float rs = rstd0[row];
#pragma unroll
                for (int bj = 0; bj < 2; ++bj) { const int c0 = u.pn * 256 + bj * 128 + wc * 32 + 8 * fq;
                    float v[8];
#pragma unroll
                    for (int j = 0; j < 8; ++j) v[j] = rs * acc[ai][bj][m][j >> 2][j & 3];
                    if (u.pn < 7) { *(u32x4*)(RW + (size_t)row * RW_COLS + c0) = pack8(v); }
                    else if (u.pn < 25) {
                        const int cq = c0 - RW_COLS, which = cq / 1536, hc = cq - which * 1536, head = hc >> 6, d = hc & 63, sh = 2 * (head >> 3);
                        const int b = row >> 13, s = row & 8191, prow = (b << 13) + ((s & ((1 << sh) - 1)) << (13 - sh)) + (s >> sh);
                        if (which == 0) {
#pragma unroll
                            for (int j = 0; j < 8; ++j) v[j] *= QSCALE;
                        }
                        *(u32x4*)(QKV + ((size_t)(which * NHEAD_A + head) * T_TOK + prow) * 64 + d) = pack8(v);
                    } else {
#pragma unroll
                        for (int j = 0; j < 8; ++j) v[j] = sigmoidf_(v[j]);
                        *(u32x4*)(GATES + (size_t)row * 2048 + (c0 - 6400)) = pack8(v);
                    } } }
    }
};
template <int MODE> struct EpiGate {
    static constexpr bool PERM = true;
    const bf16_t* GATES; const bf16_t* TMP; bf16_t* O;
    __device__ __forceinline__ void operator()(const f32x4 (&acc)[2][2][4][2], const Unit& u, int wr, int wc, int fr, int fq) const {
        asm volatile("" : "+v"(fr), "+v"(fq));
#pragma unroll
        for (int ai = 0; ai < 2; ++ai)
#pragma unroll
            for (int m = 0; m < 4; ++m) { const int row = u.pm * 256 + ai * 128 + wr * 64 + m * 16 + fr;
#pragma unroll
                for (int bj = 0; bj < 2; ++bj) { const int c0 = u.pn * 256 + bj * 128 + wc * 32 + 8 * fq;
                    float g[8], t[8], v[8]; unpack8(*(const u32x4*)(GATES + (size_t)row * 2048 + (MODE == 0 ? 0 : 1024) + c0), g);
                    if (MODE == 1) unpack8(*(const u32x4*)(TMP + (size_t)row * 1024 + c0), t);
#pragma unroll
                    for (int j = 0; j < 8; ++j) { v[j] = g[j] * acc[ai][bj][m][j >> 2][j & 3]; if (MODE == 1) v[j] += t[j]; }
                    *(u32x4*)(O + (size_t)row * 1024 + c0) = pack8(v); } }
    }
};
struct EpiResid {
    static constexpr bool PERM = true;
    const float* x; bf16_t* X1;
    __device__ __forceinline__ void operator()(const f32x4 (&acc)[2][2][4][2], const Unit& u, int wr, int wc, int fr, int fq) const {
        asm volatile("" : "+v"(fr), "+v"(fq));
#pragma unroll
        for (int ai = 0; ai < 2; ++ai)
#pragma unroll
            for (int m = 0; m < 4; ++m) { const int row = u.pm * 256 + ai * 128 + wr * 64 + m * 16 + fr;
#pragma unroll
                for (int bj = 0; bj < 2; ++bj) { const int c0 = u.pn * 256 + bj * 128 + wc * 32 + 8 * fq;
                    const f32x4 x0 = *(const f32x4*)(x + (size_t)row * 1024 + c0), x1 = *(const f32x4*)(x + (size_t)row * 1024 + c0 + 4);
                    const f32x4 v0 = acc[ai][bj][m][0] + x0, v1 = acc[ai][bj][m][1] + x1;
                    u32x4 w; w.x = pk2(v0[0], v0[1]); w.y = pk2(v0[2], v0[3]); w.z = pk2(v1[0], v1[1]); w.w = pk2(v1[2], v1[3]);
                    *(u32x4*)(X1 + (size_t)row * 1024 + c0) = w; } }
    }
};

constexpr int ATT_LD = 72, ATT_KOFF = 0, ATT_VOFF = 384 * ATT_LD * 2;
__device__ __forceinline__ bf16x8 pack_frag(const f32x16& p, int s) {
    u32x4 w; w.x = pk2(p[8 * s + 0], p[8 * s + 1]); w.y = pk2(p[8 * s + 2], p[8 * s + 3]); w.z = pk2(p[8 * s + 4], p[8 * s + 5]); w.w = pk2(p[8 * s + 6], p[8 * s + 7]);
    return __builtin_bit_cast(bf16x8, w);
}
__device__ __forceinline__ void attn_phase(Frame& F) {
    const int w = F.wave;
    bf16_t* Qg = (bf16_t*)(F.ws + WS_Q); const bf16_t* Kg = (const bf16_t*)(F.ws + WS_K); const bf16_t* Vg = (const bf16_t*)(F.ws + WS_V);
    float* LSE = (float*)(F.ws + WS_LSE);
    LAS unsigned char* lds = F.lds;
    for (int uid = F.vcu; uid < 1536; uid += F.G) {
        const int tid = otid(), lane = tid & 63, r32 = lane & 31, hi = lane >> 5;
        const int head = uid >> 6, b = (uid >> 5) & 1, u32i = uid & 31, grp = head >> 3, sh = 2 * grp, nqb = 32 >> sh, qb = u32i & (nqb - 1);
        const int base = (b << 13) + u32i * 256;
        const float slope2 = __builtin_amdgcn_exp2f(-(float)(head + 1) * (1.0f / 3.0f)) * (float)(1 << sh) * LOG2E;
#pragma unroll
        for (int i = 0; i < 6; ++i) { const int idx = tid + 512 * i, row = idx >> 3, ch = idx & 7;
            u32x4 kv = (u32x4){0u, 0u, 0u, 0u}, vv = kv;
            if (qb > 0 || row >= 128) { const size_t g = ((size_t)head * T_TOK + base - 128 + row) * 64 + ch * 8; kv = *(const u32x4*)(Kg + g); vv = *(const u32x4*)(Vg + g); }
            *(LAS u32x4*)(lds + ATT_KOFF + row * (ATT_LD * 2) + ch * 16) = kv; *(LAS u32x4*)(lds + ATT_VOFF + row * (ATT_LD * 2) + ch * 16) = vv; }
        bf16x8 qf[4];
        { const bf16_t* qp = Qg + ((size_t)head * T_TOK + base + 32 * w + r32) * 64 + 8 * hi;
#pragma unroll
          for (int ks = 0; ks < 4; ++ks) qf[ks] = *(const bf16x8*)(qp + 16 * ks); }
        __syncthreads();
        f32x16 sc[5];
#pragma unroll
        for (int kb = 0; kb < 5; ++kb) {
            f32x16 a = {};
            const LAS unsigned char* kp = lds + ATT_KOFF + (32 * w + 32 * kb + r32) * (ATT_LD * 2) + 16 * hi;
#pragma unroll
            for (int ks = 0; ks < 4; ++ks) a = __builtin_amdgcn_mfma_f32_32x32x16_bf16(*(const LAS bf16x8*)(kp + 32 * ks), qf[ks], a, 0, 0, 0);
            sc[kb] = a;
        }
        float mx = -3.0e38f;
#pragma unroll
        for (int kb = 0; kb < 5; ++kb)
#pragma unroll
            for (int r = 0; r < 16; ++r) {
                const int kr = crow(r, hi), delta = 128 - 32 * kb + r32 - kr, kl = 32 * w + 32 * kb + kr;
                const bool valid = (delta >= 0) && (delta <= 128) && (qb > 0 || kl >= 128);
                const float s = valid ? (sc[kb][r] - slope2 * (float)delta) : -3.0e38f;
                sc[kb][r] = s; mx = fmaxf(mx, s);
            }
        mx = fmaxf(mx, __shfl_xor(mx, 32));
        float l = 0.f;
#pragma unroll
        for (int kb = 0; kb < 5; ++kb)
#pragma unroll
            for (int r = 0; r < 16; ++r) { const float p = (sc[kb][r] > -1.0e38f) ? __builtin_amdgcn_exp2f(sc[kb][r] - mx) : 0.f; sc[kb][r] = p; l += p; }
        l += __shfl_xor(l, 32);
        f32x16 o[2] = {};
#pragma unroll
        for (int kb = 0; kb < 5; ++kb)
#pragma unroll
            for (int s = 0; s < 2; ++s) {
                const bf16x8 pa = pack_frag(sc[kb], s);
#pragma unroll
                for (int dt = 0; dt < 2; ++dt) {
                    const LAS unsigned char* vp = lds + ATT_VOFF + (32 * w + 32 * kb + 16 * s + 4 * hi) * (ATT_LD * 2) + (32 * dt + r32) * 2;
                    bf16x8 vb;
#pragma unroll
                    for (int e = 0; e < 8; ++e) vb[e] = *(const LAS short*)(vp + (8 * (e >> 2) + (e & 3)) * (ATT_LD * 2));
                    o[dt] = __builtin_amdgcn_mfma_f32_32x32x16_bf16(pa, vb, o[dt], 0, 0, 0);
                }
            }
        const float linv = 1.0f / l;
        bf16_t* op = Qg + ((size_t)head * T_TOK + base + 32 * w) * 64;
#pragma unroll
        for (int r = 0; r < 16; ++r) { const int q = crow(r, hi); const float li = __shfl(linv, q);
#pragma unroll
            for (int dt = 0; dt < 2; ++dt) op[(size_t)q * 64 + 32 * dt + r32] = (bf16_t)f2bf(o[dt][r] * li); }
        if (hi == 0) LSE[(size_t)head * T_TOK + base + 32 * w + r32] = mx + __builtin_amdgcn_logf(l);
        __syncthreads();
    }
}
__device__ __forceinline__ void combine_phase(Frame& F, int gtid, int ngt) {
    if (gtid < 0) return;
    const bf16_t* Og = (const bf16_t*)(F.ws + WS_Q); const float* LSE = (const float*)(F.ws + WS_LSE); bf16_t* YB = (bf16_t*)(F.ws + WS_A1);
    for (int it = gtid; it < T_TOK * 64; it += ngt) {
        const int t = it >> 6, j = (it >> 3) & 7, oc = it & 7, b = t >> 13, s = t & 8191;
        float ls[3], ov[3][8];
#pragma unroll
        for (int g = 0; g < 3; ++g) { const int sh = 2 * g, head = 8 * g + j, prow = (b << 13) + ((s & ((1 << sh) - 1)) << (13 - sh)) + (s >> sh);
            ls[g] = LSE[(size_t)head * T_TOK + prow]; unpack8(*(const u32x4*)(Og + ((size_t)head * T_TOK + prow) * 64 + oc * 8), ov[g]); }
        const float m = fmaxf(ls[0], fmaxf(ls[1], ls[2]));
        const float w0 = __builtin_amdgcn_exp2f(ls[0] - m), w1 = __builtin_amdgcn_exp2f(ls[1] - m), w2 = __builtin_amdgcn_exp2f(ls[2] - m), inv = 1.0f / (w0 + w1 + w2);
        float v[8];
#pragma unroll
        for (int e = 0; e < 8; ++e) v[e] = (w0 * ov[0][e] + w1 * ov[1][e] + w2 * ov[2][e]) * inv;
        *(u32x4*)(YB + (size_t)t * 512 + j * 64 + oc * 8) = pack8(v);
    }
}

__device__ __forceinline__ void wr_phase(Frame& F, int gtid, int ngt) {
    if (gtid < 0) return;
    float* WR = (float*)(F.ws + WS_WR); const float* wg = F.in[19]; const float* we = F.in[20]; const float* gain = F.in[18];
    for (int i = gtid; i < 36 * 1024; i += ngt) { const int o = i >> 10, k = i & 1023;
        const float w = (o < 4) ? wg[k * 4 + o] : we[((size_t)((o - 4) >> 3) * 1024 + k) * 8 + ((o - 4) & 7)];
        WR[i] = w * gain[k]; }
}
__device__ __forceinline__ void router_phase(Frame& F) {
    const int gw = F.vcu * NWAVES + F.wave, NGW = F.G * NWAVES, lane = otid() & 63;
    const bf16_t* X1 = (const bf16_t*)(F.ws + WS_X1); const float* WR = (const float*)(F.ws + WS_WR);
    float* rstd1 = (float*)(F.ws + WS_RSTD1); unsigned* cnt = (unsigned*)(F.ctl + CW_CNT);
    unsigned* LIST = (unsigned*)(F.ws + WS_LIST); float* LISTW = (float*)(F.ws + WS_LISTW);
    for (int m0 = gw * 4; m0 < T_TOK; m0 += NGW * 4) {
        float x[4][16]; float rs[4];
#pragma unroll
        for (int q = 0; q < 4; ++q) { const bf16_t* xr = X1 + (size_t)(m0 + q) * 1024;
            unpack8(*(const u32x4*)(xr + lane * 8), x[q]); unpack8(*(const u32x4*)(xr + 512 + lane * 8), x[q] + 8);
            float s = 0.f;
#pragma unroll
            for (int j = 0; j < 16; ++j) s += x[q][j] * x[q][j];
            s = wave_sum(s); rs[q] = 1.0f / sqrtf(s * (1.0f / 1024.0f) + NORM_EPS); }
        float lg[4][36];
        for (int o = 0; o < 36; ++o) {
            const float* wr = WR + o * 1024;
            const f32x4 w0 = *(const f32x4*)(wr + lane * 8), w1 = *(const f32x4*)(wr + lane * 8 + 4), w2 = *(const f32x4*)(wr + 512 + lane * 8), w3 = *(const f32x4*)(wr + 512 + lane * 8 + 4);
#pragma unroll
            for (int q = 0; q < 4; ++q) {
                float s = x[q][0] * w0.x + x[q][1] * w0.y + x[q][2] * w0.z + x[q][3] * w0.w + x[q][4] * w1.x + x[q][5] * w1.y + x[q][6] * w1.z + x[q][7] * w1.w
                        + x[q][8] * w2.x + x[q][9] * w2.y + x[q][10] * w2.z + x[q][11] * w2.w + x[q][12] * w3.x + x[q][13] * w3.y + x[q][14] * w3.z + x[q][15] * w3.w;
                s = wave_sum(s);
                lg[q][0] = (lane == o) ? s * rs[q] : lg[q][0];
            }
        }
#pragma unroll
        for (int q = 0; q < 4; ++q) {
            const float v = lg[q][0];
            float gl[4];
#pragma unroll
            for (int g = 0; g < 4; ++g) gl[g] = __shfl(v, g);
            int gi = 0; float gm = gl[0];
#pragma unroll
            for (int g = 1; g < 4; ++g) if (gl[g] > gm) { gm = gl[g]; gi = g; }
            float den = 0.f;
#pragma unroll
            for (int g = 0; g < 4; ++g) den += __expf(gl[g] - gm);
            const float gwt = 1.0f / den;
            float el[8];
#pragma unroll
            for (int e = 0; e < 8; ++e) el[e] = __shfl(v, 4 + gi * 8 + e);
            int i1 = 0; float v1 = el[0];
#pragma unroll
            for (int e = 1; e < 8; ++e) if (el[e] > v1) { v1 = el[e]; i1 = e; }
            int i2 = -1; float v2 = -3.0e38f;
#pragma unroll
            for (int e = 0; e < 8; ++e) if (e != i1 && el[e] > v2) { v2 = el[e]; i2 = e; }
            const float w1 = 1.0f / (1.0f + __expf(v2 - v1)), w2 = 1.0f - w1;
            if (lane == 0) {
                const int m = m0 + q; rstd1[m] = rs[q];
                const int e1 = gi * 8 + i1, e2 = gi * 8 + i2;
                const unsigned p1 = atomicAdd(cnt + e1, 1u); LIST[(size_t)e1 * T_TOK + p1] = (unsigned)m * 2u; LISTW[(size_t)e1 * T_TOK + p1] = w1 * gwt;
                const unsigned p2 = atomicAdd(cnt + e2, 1u); LIST[(size_t)e2 * T_TOK + p2] = (unsigned)m * 2u + 1u; LISTW[(size_t)e2 * T_TOK + p2] = w2 * gwt;
            }
        }
    }
}
template <int NPN, bool GATHER_>
struct MoeOrder {
    const volatile LAS unsigned* cnt; const unsigned* LIST; int G, c, K, NB;
    __device__ bool next(int i, Unit& u) const {
        int L = i * G + c, prefix = 0;
        for (int e = 0; e < 32; ++e) { const int n = __builtin_amdgcn_readfirstlane((int)cnt[e]), units = ((n + 255) >> 8) * NPN;
            if (L < units) { const int rt = L / NPN; u.e = e; u.pm = rt; u.pn = L % NPN; u.nrows = (n - rt * 256) < 256 ? (n - rt * 256) : 256; u.rbase = prefix + rt * 256; return true; }
            L -= units; prefix += n; }
        return false;
    }
    static constexpr bool GATHER = GATHER_;
    __device__ __forceinline__ unsigned arow0(const Unit& u) const { return (unsigned)u.rbase; }
    __device__ __forceinline__ unsigned arow(const Unit& u, int r) const {
        const int rr = r < u.nrows ? r : u.nrows - 1;
        if (GATHER) return LIST[(size_t)u.e * T_TOK + u.pm * 256 + rr] >> 1;
        return (unsigned)(u.rbase + rr);
    }
    __device__ __forceinline__ size_t boff(const Unit& u) const { return ((size_t)u.e * NB + (size_t)u.pn * 256) * K; }
};
struct EpiMoeHid {
    static constexpr bool PERM = true;
    const unsigned* LIST; const float* LISTW; const float* rstd1; bf16_t* HID;
    __device__ __forceinline__ void operator()(const f32x4 (&acc)[2][2][4][2], const Unit& u, int wr, int wc, int fr, int fq) const {
        asm volatile("" : "+v"(fr), "+v"(fq));
#pragma unroll
        for (int ai = 0; ai < 2; ++ai)
#pragma unroll
            for (int m = 0; m < 4; ++m) { const int r = ai * 128 + wr * 64 + m * 16 + fr;
                if (r < u.nrows) { const size_t li = (size_t)u.e * T_TOK + u.pm * 256 + r; const unsigned tok = LIST[li] >> 1; const float w = LISTW[li], rs = rstd1[tok];
                    float h[8];
#pragma unroll
                    for (int j = 0; j < 8; ++j) { const float g = rs * acc[ai][0][m][j >> 2][j & 3], up = rs * acc[ai][1][m][j >> 2][j & 3]; h[j] = g * sigmoidf_(g) * up * w; }
                    *(u32x4*)(HID + (size_t)(u.rbase + r) * 256 + u.pn * 128 + wc * 32 + 8 * fq) = pack8(h); } }
    }
};
struct EpiMoeOut {
    static constexpr bool PERM = true;
    const unsigned* LIST; bf16_t* MO;
    __device__ __forceinline__ void operator()(const f32x4 (&acc)[2][2][4][2], const Unit& u, int wr, int wc, int fr, int fq) const {
        asm volatile("" : "+v"(fr), "+v"(fq));
#pragma unroll
        for (int ai = 0; ai < 2; ++ai)
#pragma unroll
            for (int m = 0; m < 4; ++m) { const int r = ai * 128 + wr * 64 + m * 16 + fr;
                if (r < u.nrows) { const unsigned en = LIST[(size_t)u.e * T_TOK + u.pm * 256 + r]; const unsigned tok = en >> 1, slot = en & 1u;
#pragma unroll
                    for (int bj = 0; bj < 2; ++bj) { const f32x4 v0 = acc[ai][bj][m][0], v1 = acc[ai][bj][m][1];
                        u32x4 w; w.x = pk2(v0[0], v0[1]); w.y = pk2(v0[2], v0[3]); w.z = pk2(v1[0], v1[1]); w.w = pk2(v1[2], v1[3]);
                        *(u32x4*)(MO + ((size_t)slot * T_TOK + tok) * 1024 + u.pn * 256 + bj * 128 + wc * 32 + 8 * fq) = w; } } }
    }
};
__device__ __forceinline__ void load_counts(Frame& F, volatile LAS unsigned* cl) {
    __syncthreads();
    const int tid = otid();
    if (tid < 32) cl[tid] = __hip_atomic_load((unsigned*)(F.ctl + CW_CNT) + tid, RLX_AGENT);
    __syncthreads();
}

constexpr int LDF = 68, LDH = 72;
constexpr int L_AB = 0, L_R2 = 17408, L_AAB = 34816, L_RB = 52224, L_BT = 61440, L_KT = 70656, L_V = 79872, L_AAK = 89088, L_ARB = 98304, L_ARK = 107520, L_T = 116736, L_GC = 120832, L_SEG = 121088;
constexpr int L_TW = L_AAK, L_TA = L_ARB;
typedef LAS unsigned char* ldsp;
__device__ __forceinline__ float tanhf_(float x) { return 1.0f - 2.0f / (__expf(2.0f * x) + 1.0f); }
__device__ __forceinline__ float softplusf_(float x) { return x > 20.f ? x : __logf(1.0f + __expf(x)); }
__device__ __forceinline__ bf16x8 cvt8(const float* f) { return __builtin_bit_cast(bf16x8, pack8(f)); }
__device__ __forceinline__ bf16x8 ld_kc_h(ldsp m, int nk, int k0) { return *(const LAS bf16x8*)(m + nk * (LDH * 2) + k0 * 2); }
__device__ __forceinline__ bf16x8 ld_kc_f(ldsp m, int nk, int k0) { const LAS float* p = (const LAS float*)(m + (nk * LDF + k0) * 4); const f32x4 a = *(const LAS f32x4*)p, b = *(const LAS f32x4*)(p + 4);
    float f[8] = {a[0], a[1], a[2], a[3], b[0], b[1], b[2], b[3]}; return cvt8(f); }
__device__ __forceinline__ bf16x8 ld_ks_h(ldsp m, int nk, int k0) { bf16x8 v;
#pragma unroll
    for (int e = 0; e < 8; ++e) v[e] = *(const LAS short*)(m + (k0 + e) * (LDH * 2) + nk * 2);
    return v; }
__device__ __forceinline__ bf16x8 ld_ks_f(ldsp m, int nk, int k0) { float f[8];
#pragma unroll
    for (int e = 0; e < 8; ++e) f[e] = *(const LAS float*)(m + ((k0 + e) * LDF + nk) * 4);
    return cvt8(f); }
__device__ __forceinline__ u32x4 pk_acc8(const f32x16& a, int s) { u32x4 w; w.x = pk2(a[8 * s], a[8 * s + 1]); w.y = pk2(a[8 * s + 2], a[8 * s + 3]); w.z = pk2(a[8 * s + 4], a[8 * s + 5]); w.w = pk2(a[8 * s + 6], a[8 * s + 7]); return w; }
#define MFMA32(a, b, c) __builtin_amdgcn_mfma_f32_32x32x16_bf16(a, b, c, 0, 0, 0)

__device__ __forceinline__ void rwkv_prep_phase(Frame& F) {
    const bf16_t* RW = (const bf16_t*)(F.ws + WS_RW);
    const bf16_t* W2T = (const bf16_t*)(F.ws + WS_W2T); const bf16_t* A2T = (const bf16_t*)(F.ws + WS_A2T);
    float* RK = (float*)(F.ws + WS_RK);
    u32x4* PF = (u32x4*)(F.ws + WS_PF); u32x4* GF = (u32x4*)(F.ws + WS_GF); u32x4* QF = (u32x4*)(F.ws + WS_QF); u32x4* YF = (u32x4*)(F.ws + WS_YF);
    const float* mu = F.in[4]; const float* w0p = F.in[5]; const float* a0p = F.in[7]; const float* kkp = F.in[10]; const float* kap = F.in[11]; const float* rkp_ = F.in[12];
    const ldsp lds = F.lds; const int w = F.wave;
    for (int cid = F.vcu; cid < 2048; cid += F.G) {
        const int tid = otid(), lane = tid & 63, r32 = lane & 31, hi = lane >> 5;
        const int bh = cid >> 7, cidx = cid & 127, b = bh >> 3, h = bh & 7;
        const int tok0 = b * SEQ + cidx * 64;
        const int t_e = tid >> 3, oct = tid & 7, tok_e = tok0 + t_e; const bool has_prev = (cidx * 64 + t_e) > 0;
#pragma unroll
        for (int i = 0; i < 3; ++i) {
            const int col = (i == 0 ? 1536 : i == 1 ? 1600 : 1024 + h * 64) + oct * 8;
            float cur[8], prv[8], z[8]; unpack8(*(const u32x4*)(RW + (size_t)tok_e * RW_COLS + col), cur);
            if (has_prev) unpack8(*(const u32x4*)(RW + (size_t)(tok_e - 1) * RW_COLS + col), prv); else {
#pragma unroll
                for (int e = 0; e < 8; ++e) prv[e] = 0.f; }
            const f32x4 m0 = *(const f32x4*)(mu + col), m1 = *(const f32x4*)(mu + col + 4);
#pragma unroll
            for (int e = 0; e < 8; ++e) { const float m = e < 4 ? m0[e & 3] : m1[e & 3]; z[e] = cur[e] + (prv[e] - cur[e]) * m; if (i == 0) z[e] = tanhf_(z[e]); }
            *(LAS u32x4*)(lds + (i == 0 ? L_TW : i == 1 ? L_TA : L_V) + t_e * (LDH * 2) + oct * 16) = pack8(z);
        }
        __syncthreads();
        {
            const int which = w >> 2, tb = (w >> 1) & 1, jb = w & 1;
            const ldsp am = lds + (which ? L_TA : L_TW); const bf16_t* bw = (which ? A2T : W2T) + (size_t)(h * 64 + 32 * jb + r32) * 64 + 8 * hi;
            f32x16 acc = {};
#pragma unroll
            for (int ks = 0; ks < 4; ++ks) acc = MFMA32(ld_kc_h(am, 32 * tb + r32, 16 * ks + 8 * hi), *(const bf16x8*)(bw + 16 * ks), acc);
            LAS float* om = (LAS float*)(lds + (which ? L_AAB : L_R2));
#pragma unroll
            for (int r = 0; r < 16; ++r) om[(32 * tb + crow(r, hi)) * LDF + 32 * jb + r32] = acc[r];
        }
        __syncthreads();
        const int j0 = oct * 8, cj = h * 64 + j0;
        float rr[8], kq[8], kk[8], aa[8], lw[8];
        {
            float cur[8], prv[8], k0[8];
            unpack8(*(const u32x4*)(RW + (size_t)tok_e * RW_COLS + cj), cur);
            if (has_prev) unpack8(*(const u32x4*)(RW + (size_t)(tok_e - 1) * RW_COLS + cj), prv); else {
#pragma unroll
                for (int e = 0; e < 8; ++e) prv[e] = 0.f; }
#pragma unroll
            for (int e = 0; e < 8; ++e) rr[e] = cur[e] + (prv[e] - cur[e]) * mu[cj + e];
            unpack8(*(const u32x4*)(RW + (size_t)tok_e * RW_COLS + 512 + cj), cur);
            if (has_prev) unpack8(*(const u32x4*)(RW + (size_t)(tok_e - 1) * RW_COLS + 512 + cj), prv);
#pragma unroll
            for (int e = 0; e < 8; ++e) k0[e] = cur[e] + (prv[e] - cur[e]) * mu[512 + cj + e];
            const LAS float* lwp = (const LAS float*)(lds + L_R2) + t_e * LDF + j0; const LAS float* lap = (const LAS float*)(lds + L_AAB) + t_e * LDF + j0;
            float ss = 0.f, rks = 0.f;
#pragma unroll
            for (int e = 0; e < 8; ++e) {
                const float wl = -softplusf_(-(w0p[cj + e] + lwp[e])) - 0.5f;
                lw[e] = -__expf(wl);
                aa[e] = sigmoidf_(a0p[cj + e] + lap[e]);
                const float kr = k0[e] * kkp[cj + e]; kk[e] = kr; ss += kr * kr;
                kq[e] = k0[e] * (1.0f + (aa[e] - 1.0f) * kap[cj + e]);
                rks += rr[e] * kq[e] * rkp_[cj + e];
            }
            ss += __shfl_xor(ss, 1); ss += __shfl_xor(ss, 2); ss += __shfl_xor(ss, 4);
            rks += __shfl_xor(rks, 1); rks += __shfl_xor(rks, 2); rks += __shfl_xor(rks, 4);
            const float inv = 1.0f / sqrtf(ss + 1e-12f);
#pragma unroll
            for (int e = 0; e < 8; ++e) kk[e] *= inv;
            if (oct == 0) RK[(size_t)tok_e * 8 + h] = rks;
            LAS float* lo = (LAS float*)(lds + L_AAB) + t_e * LDF + j0;
#pragma unroll
            for (int e = 0; e < 8; ++e) lo[e] = lw[e];
        }
        __syncthreads();
        {
            const int j = tid & 63, sg = tid >> 6; LAS float* cp = (LAS float*)(lds + L_AAB) + (8 * sg) * LDF + j; float run = 0.f;
#pragma unroll
            for (int q = 0; q < 8; ++q) { run += cp[q * LDF]; cp[q * LDF] = run; }
            ((LAS float*)(lds + L_SEG))[sg * 64 + j] = run;
        }
        __syncthreads();
        {
            const int sg = t_e >> 3; const LAS float* lg = (const LAS float*)(lds + L_AAB) + t_e * LDF + j0; const LAS float* sp = (const LAS float*)(lds + L_SEG) + j0;
            float rb[8], ab[8], bt[8], kt[8];
#pragma unroll
            for (int e = 0; e < 8; ++e) {
                float pre = 0.f;
                for (int q = 0; q < sg; ++q) pre += sp[q * 64 + e];
                const float L = lg[e] + pre, gm = __expf(L), gp = __expf(L - lw[e]), gi = __expf(-L);
                rb[e] = rr[e] * gm; ab[e] = -kk[e] * gp; bt[e] = kk[e] * aa[e] * gi; kt[e] = kq[e] * gi;
                if (t_e == 63) ((LAS float*)(lds + L_GC))[j0 + e] = gm;
            }
            LAS float* abp = (LAS float*)(lds + L_AB) + t_e * LDF + j0;
#pragma unroll
            for (int e = 0; e < 8; ++e) abp[e] = ab[e];
            *(LAS u32x4*)(lds + L_RB + t_e * (LDH * 2) + oct * 16) = pack8(rb);
            *(LAS u32x4*)(lds + L_BT + t_e * (LDH * 2) + oct * 16) = pack8(bt);
            *(LAS u32x4*)(lds + L_KT + t_e * (LDH * 2) + oct * 16) = pack8(kt);
        }
        __syncthreads();
#pragma unroll
        for (int i = 0; i < 2; ++i) {
            const int q = 2 * w + i, rm = q >> 3, cm = (q >> 2) & 1, tb = (q >> 1) & 1, sb = q & 1;
            f32x16 acc = {};
            if (sb <= tb) {
                const ldsp bm = lds + (cm ? L_KT : L_BT);
#pragma unroll
                for (int ks = 0; ks < 4; ++ks) {
                    const bf16x8 af = rm ? ld_kc_h(lds + L_RB, 32 * tb + r32, 16 * ks + 8 * hi) : ld_kc_f(lds + L_AB, 32 * tb + r32, 16 * ks + 8 * hi);
                    acc = MFMA32(af, ld_kc_h(bm, 32 * sb + r32, 16 * ks + 8 * hi), acc);
                }
            }
            const int s = 32 * sb + r32;
#pragma unroll
            for (int r = 0; r < 16; ++r) { const int t = 32 * tb + crow(r, hi); const bool keep = rm ? (s <= t) : (s < t); const float v = keep ? acc[r] : 0.f;
                if (rm == 0 && cm == 0) ((LAS float*)(lds + L_AAB))[t * LDF + s] = v;
                else *(LAS unsigned short*)(lds + (rm == 0 ? L_AAK : cm == 0 ? L_ARB : L_ARK) + t * (LDH * 2) + s * 2) = (unsigned short)f2bf(v); }
        }
        __syncthreads();
        if (w < 4) {
            const int tb = w >> 1, vb = w & 1; f32x16 acc = {};
#pragma unroll
            for (int ks = 0; ks < 4; ++ks) acc = MFMA32(ld_kc_h(lds + L_AAK, 32 * tb + r32, 16 * ks + 8 * hi), ld_ks_h(lds + L_V, 32 * vb + r32, 16 * ks + 8 * hi), acc);
#pragma unroll
            for (int r = 0; r < 16; ++r) ((LAS float*)(lds + L_R2))[(32 * tb + crow(r, hi)) * LDF + 32 * vb + r32] = acc[r];
        } else if (w == 4) {
            const int blk = lane >> 4, c = lane & 15; const LAS float* ap = (const LAS float*)(lds + L_AAB) + (16 * blk) * LDF + 16 * blk;
            float tv[16];
#pragma unroll
            for (int t = 0; t < 16; ++t) { float x = (t == c) ? 1.0f : 0.0f;
#pragma unroll
                for (int s = 0; s < t; ++s) x += ap[t * LDF + s] * tv[s];
                tv[t] = x; ((LAS float*)(lds + L_T))[(blk * 16 + t) * 16 + c] = x; }
        }
        __syncthreads();
        {
            const int cl = lane & 15, g = lane >> 4; LAS float* M = (LAS float*)(lds + (w < 4 ? L_AB : L_R2)) + 16 * (w & 3) + cl;
            const LAS float* Aab = (const LAS float*)(lds + L_AAB); const LAS float* Tm = (const LAS float*)(lds + L_T);
            f32x4 x[4];
#pragma unroll
            for (int i = 0; i < 4; ++i) {
                f32x4 acc;
#pragma unroll
                for (int r = 0; r < 4; ++r) acc[r] = M[(16 * i + 4 * g + r) * LDF];
#pragma unroll
                for (int jb = 0; jb < i; ++jb)
#pragma unroll
                    for (int kx = 0; kx < 4; ++kx) acc = __builtin_amdgcn_mfma_f32_16x16x4f32(Aab[(16 * i + cl) * LDF + 16 * jb + 4 * g + kx], x[jb][kx], acc, 0, 0, 0);
                f32x4 a2 = {0.f, 0.f, 0.f, 0.f};
#pragma unroll
                for (int kx = 0; kx < 4; ++kx) a2 = __builtin_amdgcn_mfma_f32_16x16x4f32(Tm[(i * 16 + cl) * 16 + 4 * g + kx], acc[kx], a2, 0, 0, 0);
                x[i] = a2;
#pragma unroll
                for (int r = 0; r < 4; ++r) M[(16 * i + 4 * g + r) * LDF] = a2[r];
            }
        }
        __syncthreads();
        const LAS float* GC = (const LAS float*)(lds + L_GC);
        if (w < 4) {
            const int kb = w >> 1, jb = w & 1; f32x16 acc = {};
#pragma unroll
            for (int ks = 0; ks < 4; ++ks) acc = MFMA32(ld_ks_f(lds + L_AB, 32 * kb + r32, 16 * ks + 8 * hi), ld_ks_h(lds + L_BT, 32 * jb + r32, 16 * ks + 8 * hi), acc);
            const int j = 32 * jb + r32; const float gc = GC[j];
#pragma unroll
            for (int r = 0; r < 16; ++r) acc[r] = gc * (acc[r] + ((32 * kb + crow(r, hi)) == j ? 1.0f : 0.0f));
#pragma unroll
            for (int s = 0; s < 2; ++s) PF[((size_t)(cid * 2 + jb) * 4 + 2 * kb + s) * 64 + lane] = pk_acc8(acc, s);
            const int jb2 = w >> 1, vb = w & 1; f32x16 g = {};
#pragma unroll
            for (int ks = 0; ks < 4; ++ks) g = MFMA32(ld_ks_h(lds + L_BT, 32 * jb2 + r32, 16 * ks + 8 * hi), ld_ks_f(lds + L_R2, 32 * vb + r32, 16 * ks + 8 * hi), g);
#pragma unroll
            for (int ks = 0; ks < 4; ++ks) g = MFMA32(ld_ks_h(lds + L_KT, 32 * jb2 + r32, 16 * ks + 8 * hi), ld_ks_h(lds + L_V, 32 * vb + r32, 16 * ks + 8 * hi), g);
#pragma unroll
            for (int r = 0; r < 16; ++r) g[r] *= GC[32 * jb2 + crow(r, hi)];
            u32x4* gp = GF + ((size_t)(cid * 2 + vb) * 2 + jb2) * 128 + lane * 2; gp[0] = pk_acc8(g, 0); gp[1] = pk_acc8(g, 1);
        } else {
            const int jb = (w >> 1) & 1, tb = w & 1; f32x16 acc = {};
#pragma unroll
            for (int ks = 0; ks < 4; ++ks) acc = MFMA32(ld_ks_f(lds + L_AB, 32 * jb + r32, 16 * ks + 8 * hi), ld_kc_h(lds + L_ARB, 32 * tb + r32, 16 * ks + 8 * hi), acc);
            const int t = 32 * tb + r32;
#pragma unroll
            for (int r = 0; r < 16; ++r) acc[r] += bf2f(*(const LAS unsigned short*)(lds + L_RB + t * (LDH * 2) + (32 * jb + crow(r, hi)) * 2));
#pragma unroll
            for (int s = 0; s < 2; ++s) QF[((size_t)(cid * 2 + tb) * 4 + 2 * jb + s) * 64 + lane] = pk_acc8(acc, s);
            const int vb = (w >> 1) & 1, tb2 = w & 1; f32x16 y = {};
#pragma unroll
            for (int ks = 0; ks < 4; ++ks) y = MFMA32(ld_ks_f(lds + L_R2, 32 * vb + r32, 16 * ks + 8 * hi), ld_kc_h(lds + L_ARB, 32 * tb2 + r32, 16 * ks + 8 * hi), y);
#pragma unroll
            for (int ks = 0; ks < 4; ++ks) y = MFMA32(ld_ks_h(lds + L_V, 32 * vb + r32, 16 * ks + 8 * hi), ld_kc_h(lds + L_ARK, 32 * tb2 + r32, 16 * ks + 8 * hi), y);
            u32x4* yp = YF + ((size_t)(cid * 2 + tb2) * 2 + vb) * 128 + lane * 2; yp[0] = pk_acc8(y, 0); yp[1] = pk_acc8(y, 1);
        }
        __syncthreads();
    }
}

struct ScanIn { u32x4 p[2][4]; u32x4 g[2][2]; };
__device__ __forceinline__ void scan_load(ScanIn& s, const u32x4* PF, const u32x4* GF, int cid, int vh, int lane) {
#pragma unroll
    for (int jt = 0; jt < 2; ++jt)
#pragma unroll
        for (int ks = 0; ks < 4; ++ks) s.p[jt][ks] = PF[((size_t)(cid * 2 + jt) * 4 + ks) * 64 + lane];
#pragma unroll
    for (int jt = 0; jt < 2; ++jt) { const u32x4* gp = GF + ((size_t)(cid * 2 + vh) * 2 + jt) * 128 + lane * 2; s.g[jt][0] = gp[0]; s.g[jt][1] = gp[1]; }
}
__device__ __forceinline__ void scan_step(const ScanIn& s, f32x16 (&H)[2], u32x4* HF, int cid, int vh, int lane) {
    u32x4 hp[2][2];
#pragma unroll
    for (int kt = 0; kt < 2; ++kt)
#pragma unroll
        for (int sp = 0; sp < 2; ++sp) hp[kt][sp] = pk_acc8(H[kt], sp);
    f32x16 N[2];
#pragma unroll
    for (int jt = 0; jt < 2; ++jt) {
        float f[16]; unpack8(s.g[jt][0], f); unpack8(s.g[jt][1], f + 8);
#pragma unroll
        for (int r = 0; r < 16; ++r) N[jt][r] = f[r];
    }
    u32x4* hf = HF + ((size_t)(cid * 2 + vh) * 4) * 64 + lane;
#pragma unroll
    for (int kt = 0; kt < 2; ++kt)
#pragma unroll
        for (int sp = 0; sp < 2; ++sp) hf[(kt * 2 + sp) * 64] = hp[kt][sp];
#pragma unroll
    for (int kt = 0; kt < 2; ++kt)
#pragma unroll
        for (int sp = 0; sp < 2; ++sp)
#pragma unroll
            for (int jt = 0; jt < 2; ++jt) N[jt] = MFMA32(__builtin_bit_cast(bf16x8, s.p[jt][2 * kt + sp]), __builtin_bit_cast(bf16x8, hp[kt][sp]), N[jt]);
    H[0] = N[0]; H[1] = N[1];
}
__device__ __forceinline__ void rwkv_scan_wave(Frame& F, int sid) {
    const int lane = otid() & 63, bh = sid >> 1, vh = sid & 1;
    const u32x4* PF = (const u32x4*)(F.ws + WS_PF); u32x4* GF = (u32x4*)(F.ws + WS_GF);
    f32x16 H[2] = {};
    ScanIn A, B;
    scan_load(A, PF, GF, bh * 128, vh, lane);
    for (int c = 0; c < 128; c += 2) {
        scan_load(B, PF, GF, bh * 128 + c + 1, vh, lane);
        scan_step(A, H, GF, bh * 128 + c, vh, lane);
        if (c + 2 < 128) scan_load(A, PF, GF, bh * 128 + c + 2, vh, lane);
        scan_step(B, H, GF, bh * 128 + c + 1, vh, lane);
    }
}

__device__ __forceinline__ void rwkv_out_phase(Frame& F) {
    const int gw = F.vcu * NWAVES + F.wave, NGW = F.G * NWAVES;
    const bf16_t* RW = (const bf16_t*)(F.ws + WS_RW); const bf16_t* G2T = (const bf16_t*)(F.ws + WS_G2T); const float* RK = (const float*)(F.ws + WS_RK);
    const u32x4* HF = (const u32x4*)(F.ws + WS_GF); const u32x4* QF = (const u32x4*)(F.ws + WS_QF); const u32x4* YF = (const u32x4*)(F.ws + WS_YF);
    bf16_t* YA = (bf16_t*)(F.ws + WS_YA);
    const float* mu = F.in[4]; const float* lnw = F.in[13]; const float* lnb = F.in[14];
    for (int it = gw; it < 4096; it += NGW) {
        const int lane = otid() & 63, r32 = lane & 31, hi = lane >> 5;
        const int cid = it >> 1, tb = it & 1, bh = cid >> 7, cidx = cid & 127, b = bh >> 3, h = bh & 7;
        const int s_tok = cidx * 64 + 32 * tb + r32, tok = b * SEQ + s_tok; const bool has_prev = s_tok > 0;
        f32x16 y[2];
#pragma unroll
        for (int vb = 0; vb < 2; ++vb) { const u32x4* yp = YF + ((size_t)(cid * 2 + tb) * 2 + vb) * 128 + lane * 2; float f[16]; unpack8(yp[0], f); unpack8(yp[1], f + 8);
#pragma unroll
            for (int r = 0; r < 16; ++r) y[vb][r] = f[r]; }
#pragma unroll
        for (int ks = 0; ks < 4; ++ks) { const bf16x8 qf = __builtin_bit_cast(bf16x8, QF[((size_t)(cid * 2 + tb) * 4 + ks) * 64 + lane]);
#pragma unroll
            for (int vb = 0; vb < 2; ++vb) y[vb] = MFMA32(__builtin_bit_cast(bf16x8, HF[((size_t)(cid * 2 + vb) * 4 + ks) * 64 + lane]), qf, y[vb]); }
        f32x16 gt[2] = {};
#pragma unroll
        for (int ks = 0; ks < 8; ++ks) {
            const int col = 1664 + 16 * ks + 8 * hi; float cur[8], prv[8];
            unpack8(*(const u32x4*)(RW + (size_t)tok * RW_COLS + col), cur);
            if (has_prev) unpack8(*(const u32x4*)(RW + (size_t)(tok - 1) * RW_COLS + col), prv); else {
#pragma unroll
                for (int e = 0; e < 8; ++e) prv[e] = 0.f; }
#pragma unroll
            for (int e = 0; e < 8; ++e) cur[e] = sigmoidf_(cur[e] + (prv[e] - cur[e]) * mu[col + e]);
            const bf16x8 sf = cvt8(cur);
#pragma unroll
            for (int vb = 0; vb < 2; ++vb) gt[vb] = MFMA32(*(const bf16x8*)(G2T + (size_t)(h * 64 + 32 * vb + r32) * 128 + 16 * ks + 8 * hi), sf, gt[vb]);
        }
        float s1 = 0.f;
#pragma unroll
        for (int vb = 0; vb < 2; ++vb)
#pragma unroll
            for (int r = 0; r < 16; ++r) s1 += y[vb][r];
        s1 += __shfl_xor(s1, 32); const float mean = s1 * (1.0f / 64.0f);
        float s2 = 0.f;
#pragma unroll
        for (int vb = 0; vb < 2; ++vb)
#pragma unroll
            for (int r = 0; r < 16; ++r) { const float d = y[vb][r] - mean; s2 += d * d; }
        s2 += __shfl_xor(s2, 32); const float rstd = 1.0f / sqrtf(s2 * (1.0f / 64.0f) + GN_EPS);
        const float rk = RK[(size_t)tok * 8 + h];
#pragma unroll
        for (int vb = 0; vb < 2; ++vb)
#pragma unroll
            for (int q4 = 0; q4 < 4; ++q4) {
                const int v0 = 32 * vb + 8 * q4 + 4 * hi, cv = h * 64 + v0;
                const f32x4 lw4 = *(const f32x4*)(lnw + cv), lb4 = *(const f32x4*)(lnb + cv), mu4 = *(const f32x4*)(mu + 1024 + cv);
                const u32x2 vc = *(const u32x2*)(RW + (size_t)tok * RW_COLS + 1024 + cv); u32x2 vp = (u32x2){0u, 0u};
                if (has_prev) vp = *(const u32x2*)(RW + (size_t)(tok - 1) * RW_COLS + 1024 + cv);
                const float c4[4] = {bflo(vc.x), bfhi(vc.x), bflo(vc.y), bfhi(vc.y)}, p4[4] = {bflo(vp.x), bfhi(vp.x), bflo(vp.y), bfhi(vp.y)};
                float o[4];
#pragma unroll
                for (int e = 0; e < 4; ++e) { const float vs = c4[e] + (p4[e] - c4[e]) * mu4[e]; const int r = 4 * q4 + e;
                    o[e] = ((y[vb][r] - mean) * rstd * lw4[e] + lb4[e] + rk * vs) * gt[vb][r]; }
                u32x2 ov; ov.x = pk2(o[0], o[1]); ov.y = pk2(o[2], o[3]);
                *(u32x2*)(YA + (size_t)tok * 512 + cv) = ov;
            }
    }
}

#ifndef BRINGUP
#define BRINGUP 0
#endif
constexpr int NPHASE = 16;
struct Args { const float* in[28]; float* out; unsigned char* ws; int ph_lo, ph_hi, li, pad; };
__global__ void __launch_bounds__(NWAVES * 64, 2) mk_fwd(Args args) {
    extern __shared__ __attribute__((aligned(16))) unsigned char lds[];
    Frame F;
    F.lds = (LAS unsigned char*)lds;
    F.wave = __builtin_amdgcn_readfirstlane((int)threadIdx.x >> 6);
    F.G = gridDim.x; { const int bx = blockIdx.x; F.vcu = (F.G % 8 == 0) ? (bx % 8) * (F.G / 8) + bx / 8 : bx; }
    F.ws = args.ws; F.ctl = (gu32*)(args.ws + WS_CTL); F.out = args.out;
    F.in = (const __attribute__((address_space(4))) cfp_t*)__builtin_amdgcn_kernarg_segment_ptr();
    volatile LAS unsigned* MISC = (volatile LAS unsigned*)(F.lds + MISC_OFF);
    for (int u = threadIdx.x; u < (LDS_BYTES - RING_BYTES) / 4; u += NWAVES * 64) ((LAS unsigned*)(F.lds + RING_BYTES))[u] = 0u;
    __syncthreads();
    XcdBarrier bar; bar.bar = (unsigned*)(F.ctl + CW_BAR) + args.li * XCD_BAR_WORDS; bar.x = 0; bar.st = nullptr;
    if (MK_N_LAUNCHES == 1) bar = xcd_barrier_post((unsigned*)(F.ctl + CW_BAR), MISC + 8);
    const int lo = args.ph_lo, hi = args.ph_hi;
#define IN(k) (lo <= (k) && (k) < hi)
#define SEAM(k) do { if (IN(k) && IN((k) + 1)) xcd_barrier(bar); } while (0)
    const int gw = F.vcu * NWAVES + F.wave, NGW = F.G * NWAVES;
    unsigned char* ws = F.ws;

#if BRINGUP == 1
    if (IN(0)) {
        conv_jobs(F, 7, 9, gw, NGW);
        pb_phase(F, gw, NGW);
        x2prep_phase(F, 0);
        for (int m = gw * 64 + (otid() & 63); m < T_TOK; m += NGW * 64) ((float*)(ws + WS_RSS3))[m] = 0.f;
    }
    SEAM(0);
    if (IN(1)) {
        pg8::StaticOrder S; S.init(T_TOK, 1024, 256, F.G, (int)blockIdx.x);
        EpiStoreBf16 E{(bf16_t*)(ws + WS_A2), 1024};
        pg8::gemm_phase(F.lds, (const bf16_t*)(ws + WS_PB), (const bf16_t*)(ws + WS_WPPT), 256, S, E);
    }
    SEAM(1);
    if (IN(2)) {
        pg8::StaticOrder S; S.init(T_TOK, 1024, 1024, F.G, (int)blockIdx.x);
        EpiPleGate E{(const bf16_t*)(ws + WS_X2), (const bf16_t*)(ws + WS_A2), (const float*)(ws + WS_RSTD2), F.out, (float*)(ws + WS_RSS3)};
        pg8::gemm_phase(F.lds, (const bf16_t*)(ws + WS_X2), (const bf16_t*)(ws + WS_WPGT), 1024, S, E);
    }
    SEAM(2);
    if (IN(3)) final_phase(F);
#endif

#if BRINGUP == 2
    if (IN(0)) {
        conv_jobs(F, 7, 12, gw, NGW);
        pb_phase(F, gw, NGW);
        wr_phase(F, gw * 64 + (otid() & 63), NGW * 64);
        for (int m = gw; m < T_TOK; m += NGW) row_to_bf16_rstd(F.in[0] + (size_t)m * 1024, (bf16_t*)(ws + WS_X1) + (size_t)m * 1024, (float*)(ws + WS_RSTD0) + m, (otid() & 63));
        for (int m = gw * 64 + (otid() & 63); m < T_TOK; m += NGW * 64) ((float*)(ws + WS_RSS3))[m] = 0.f;
    }
    SEAM(0);
    if (IN(1)) router_phase(F);
    SEAM(1);
    if (IN(2)) {
        load_counts(F, MISC + 16);
        MoeOrder<2, true> S{MISC + 16, (const unsigned*)(ws + WS_LIST), F.G, (int)blockIdx.x, 1024, 512};
        EpiMoeHid E{(const unsigned*)(ws + WS_LIST), (const float*)(ws + WS_LISTW), (const float*)(ws + WS_RSTD1), (bf16_t*)(ws + WS_HID)};
        pg8::gemm_phase(F.lds, (const bf16_t*)(ws + WS_X1), (const bf16_t*)(ws + WS_A2), 1024, S, E);
    }
    SEAM(2);
    if (IN(3)) {
        load_counts(F, MISC + 16);
        MoeOrder<4, false> S{MISC + 16, (const unsigned*)(ws + WS_LIST), F.G, (int)blockIdx.x, 256, 1024};
        EpiMoeOut E{(const unsigned*)(ws + WS_LIST), (bf16_t*)(ws + WS_MOEOUT)};
        pg8::gemm_phase(F.lds, (const bf16_t*)(ws + WS_HID), (const bf16_t*)(ws + WS_WDT), 256, S, E);
    }
    SEAM(3);
    if (IN(4)) x2prep_phase(F, 2);
    SEAM(4);
    if (IN(5)) {
        pg8::StaticOrder S; S.init(T_TOK, 1024, 256, F.G, (int)blockIdx.x);
        EpiStoreBf16 E{(bf16_t*)(ws + WS_A2), 1024};
        pg8::gemm_phase(F.lds, (const bf16_t*)(ws + WS_PB), (const bf16_t*)(ws + WS_WPPT), 256, S, E);
    }
    SEAM(5);
    if (IN(6)) {
        pg8::StaticOrder S; S.init(T_TOK, 1024, 1024, F.G, (int)blockIdx.x);
        EpiPleGate E{(const bf16_t*)(ws + WS_X2), (const bf16_t*)(ws + WS_A2), (const float*)(ws + WS_RSTD2), F.out, (float*)(ws + WS_RSS3)};
        pg8::gemm_phase(F.lds, (const bf16_t*)(ws + WS_X2), (const bf16_t*)(ws + WS_WPGT), 1024, S, E);
    }
    SEAM(6);
    if (IN(7)) final_phase(F);
#endif

#if BRINGUP == 3
    if (IN(0)) {
        conv_jobs(F, 0, 1, gw, NGW);
        wr_phase(F, gw * 64 + (otid() & 63), NGW * 64);
        for (int m = gw; m < T_TOK; m += NGW) row_to_bf16_rstd(F.in[0] + (size_t)m * 1024, (bf16_t*)(ws + WS_A2) + (size_t)m * 1024, (float*)(ws + WS_RSTD0) + m, otid() & 63);
        for (int m = gw * 64 + (otid() & 63); m < T_TOK; m += NGW * 64) ((float*)(ws + WS_RSS3))[m] = 0.f;
    }
    SEAM(0);
    if (IN(1)) {
        pg8::StaticOrder S; S.init(T_TOK, IN_COLS, 1024, F.G, (int)blockIdx.x);
        EpiG1 E{(const float*)(ws + WS_RSTD0), (bf16_t*)(ws + WS_RW), (bf16_t*)(ws + WS_Q), (bf16_t*)F.out};
        pg8::gemm_phase(F.lds, (const bf16_t*)(ws + WS_A2), (const bf16_t*)(ws + WS_A1), 1024, S, E);
    }
    SEAM(1);
    if (IN(2)) attn_phase(F);
    SEAM(2);
    if (IN(3)) {
        conv_jobs(F, 4, 12, gw, NGW);
        pb_phase(F, gw, NGW);
        combine_phase(F, gw * 64 + (otid() & 63), NGW * 64);
    }
    SEAM(3);
    if (IN(4)) {
        pg8::StaticOrder S; S.init(T_TOK, 1024, 512, F.G, (int)blockIdx.x);
        EpiGate<2> E{(const bf16_t*)F.out, nullptr, (bf16_t*)(ws + WS_MERGED)};
        pg8::gemm_phase(F.lds, (const bf16_t*)(ws + WS_A1), (const bf16_t*)(ws + WS_WBT), 512, S, E);
    }
    SEAM(4);
    if (IN(5)) {
        pg8::StaticOrder S; S.init(T_TOK, 1024, 1024, F.G, (int)blockIdx.x);
        EpiResid E{F.in[0], (bf16_t*)(ws + WS_X1)};
        pg8::gemm_phase(F.lds, (const bf16_t*)(ws + WS_MERGED), (const bf16_t*)(ws + WS_WOT), 1024, S, E);
    }
    SEAM(5);
    if (IN(6)) router_phase(F);
    SEAM(6);
    if (IN(7)) {
        load_counts(F, MISC + 16);
        MoeOrder<2, true> S{MISC + 16, (const unsigned*)(ws + WS_LIST), F.G, (int)blockIdx.x, 1024, 512};
        EpiMoeHid E{(const unsigned*)(ws + WS_LIST), (const float*)(ws + WS_LISTW), (const float*)(ws + WS_RSTD1), (bf16_t*)(ws + WS_HID)};
        pg8::gemm_phase(F.lds, (const bf16_t*)(ws + WS_X1), (const bf16_t*)(ws + WS_A2), 1024, S, E);
    }
    SEAM(7);
    if (IN(8)) {
        load_counts(F, MISC + 16);
        MoeOrder<4, false> S{MISC + 16, (const unsigned*)(ws + WS_LIST), F.G, (int)blockIdx.x, 256, 1024};
        EpiMoeOut E{(const unsigned*)(ws + WS_LIST), (bf16_t*)(ws + WS_MOEOUT)};
        pg8::gemm_phase(F.lds, (const bf16_t*)(ws + WS_HID), (const bf16_t*)(ws + WS_WDT), 256, S, E);
    }
    SEAM(8);
    if (IN(9)) x2prep_phase(F, 2);
    SEAM(9);
    if (IN(10)) {
        pg8::StaticOrder S; S.init(T_TOK, 1024, 256, F.G, (int)blockIdx.x);
        EpiStoreBf16 E{(bf16_t*)(ws + WS_A2), 1024};
        pg8::gemm_phase(F.lds, (const bf16_t*)(ws + WS_PB), (const bf16_t*)(ws + WS_WPPT), 256, S, E);
    }
    SEAM(10);
    if (IN(11)) {
        pg8::StaticOrder S; S.init(T_TOK, 1024, 1024, F.G, (int)blockIdx.x);
        EpiPleGate E{(const bf16_t*)(ws + WS_X2), (const bf16_t*)(ws + WS_A2), (const float*)(ws + WS_RSTD2), F.out, (float*)(ws + WS_RSS3)};
        pg8::gemm_phase(F.lds, (const bf16_t*)(ws + WS_X2), (const bf16_t*)(ws + WS_WPGT), 1024, S, E);
    }
    SEAM(11);
    if (IN(12)) final_phase(F);
#endif

#if BRINGUP == 0
    if (IN(0)) {
        conv_jobs(F, 0, 4, gw, NGW);
        wr_phase(F, gw * 64 + (otid() & 63), NGW * 64);
        for (int m = gw; m < T_TOK; m += NGW) row_to_bf16_rstd(F.in[0] + (size_t)m * 1024, (bf16_t*)(ws + WS_A2) + (size_t)m * 1024, (float*)(ws + WS_RSTD0) + m, otid() & 63);
        for (int m = gw * 64 + (otid() & 63); m < T_TOK; m += NGW * 64) ((float*)(ws + WS_RSS3))[m] = 0.f;
    }
    SEAM(0);
    if (IN(1)) {
        pg8::StaticOrder S; S.init(T_TOK, IN_COLS, 1024, F.G, (int)blockIdx.x);
        EpiG1 E{(const float*)(ws + WS_RSTD0), (bf16_t*)(ws + WS_RW), (bf16_t*)(ws + WS_Q), (bf16_t*)F.out};
        pg8::gemm_phase(F.lds, (const bf16_t*)(ws + WS_A2), (const bf16_t*)(ws + WS_A1), 1024, S, E);
    }
    SEAM(1);
    if (IN(2)) attn_phase(F);
    SEAM(2);
    if (IN(3)) rwkv_prep_phase(F);
    SEAM(3);
    if (IN(4)) {
        const bool scan_wg = F.vcu < 32;
        if (scan_wg && F.wave == 0) rwkv_scan_wave(F, F.vcu);
        else {
            const int nwork = NGW - 32, wid = scan_wg ? (F.vcu * 7 + F.wave - 1) : (224 + (F.vcu - 32) * 8 + F.wave);
            conv_jobs(F, 4, 12, wid, nwork);
            pb_phase(F, wid, nwork);
            combine_phase(F, wid * 64 + (otid() & 63), nwork * 64);
        }
    }
    SEAM(4);
    if (IN(5)) rwkv_out_phase(F);
    SEAM(5);
    if (IN(6)) {
        pg8::StaticOrder S; S.init(T_TOK, 1024, 512, F.G, (int)blockIdx.x);
        EpiGate<0> E{(const bf16_t*)F.out, nullptr, (bf16_t*)(ws + WS_TMP)};
        pg8::gemm_phase(F.lds, (const bf16_t*)(ws + WS_YA), (const bf16_t*)(ws + WS_WAT), 512, S, E);
    }
    SEAM(6);
    if (IN(7)) {
        pg8::StaticOrder S; S.init(T_TOK, 1024, 512, F.G, (int)blockIdx.x);
        EpiGate<1> E{(const bf16_t*)F.out, (const bf16_t*)(ws + WS_TMP), (bf16_t*)(ws + WS_MERGED)};
        pg8::gemm_phase(F.lds, (const bf16_t*)(ws + WS_A1), (const bf16_t*)(ws + WS_WBT), 512, S, E);
    }
    SEAM(7);
    if (IN(8)) {
        pg8::StaticOrder S; S.init(T_TOK, 1024, 1024, F.G, (int)blockIdx.x);
        EpiResid E{F.in[0], (bf16_t*)(ws + WS_X1)};
        pg8::gemm_phase(F.lds, (const bf16_t*)(ws + WS_MERGED), (const bf16_t*)(ws + WS_WOT), 1024, S, E);
    }
    SEAM(8);
    if (IN(9)) router_phase(F);
    SEAM(9);
    if (IN(10)) {
        load_counts(F, MISC + 16);
        MoeOrder<2, true> S{MISC + 16, (const unsigned*)(ws + WS_LIST), F.G, (int)blockIdx.x, 1024, 512};
        EpiMoeHid E{(const unsigned*)(ws + WS_LIST), (const float*)(ws + WS_LISTW), (const float*)(ws + WS_RSTD1), (bf16_t*)(ws + WS_HID)};
        pg8::gemm_phase(F.lds, (const bf16_t*)(ws + WS_X1), (const bf16_t*)(ws + WS_A2), 1024, S, E);
    }
    SEAM(10);
    if (IN(11)) {
        load_counts(F, MISC + 16);
        MoeOrder<4, false> S{MISC + 16, (const unsigned*)(ws + WS_LIST), F.G, (int)blockIdx.x, 256, 1024};
        EpiMoeOut E{(const unsigned*)(ws + WS_LIST), (bf16_t*)(ws + WS_MOEOUT)};
        pg8::gemm_phase(F.lds, (const bf16_t*)(ws + WS_HID), (const bf16_t*)(ws + WS_WDT), 256, S, E);
    }
    SEAM(11);
    if (IN(12)) x2prep_phase(F, 2);
    SEAM(12);
    if (IN(13)) {
        pg8::StaticOrder S; S.init(T_TOK, 1024, 256, F.G, (int)blockIdx.x);
        EpiStoreBf16 E{(bf16_t*)(ws + WS_A2), 1024};
        pg8::gemm_phase(F.lds, (const bf16_t*)(ws + WS_PB), (const bf16_t*)(ws + WS_WPPT), 256, S, E);
    }
    SEAM(13);
    if (IN(14)) {
        pg8::StaticOrder S; S.init(T_TOK, 1024, 1024, F.G, (int)blockIdx.x);
        EpiPleGate E{(const bf16_t*)(ws + WS_X2), (const bf16_t*)(ws + WS_A2), (const float*)(ws + WS_RSTD2), F.out, (float*)(ws + WS_RSS3)};
        pg8::gemm_phase(F.lds, (const bf16_t*)(ws + WS_X2), (const bf16_t*)(ws + WS_WPGT), 1024, S, E);
    }
    SEAM(14);
    if (IN(15)) final_phase(F);
#endif
#undef IN
#undef SEAM
}

#if BRINGUP == 1
constexpr int NPH_USED = 4;
#elif BRINGUP == 2
constexpr int NPH_USED = 8;
#elif BRINGUP == 3
constexpr int NPH_USED = 13;
#else
constexpr int NPH_USED = NPHASE;
#endif

extern "C" void kernel_launch(void* const* d_in, const int* in_sizes, int n_in, void* d_out, int out_size, void* d_ws, size_t ws_size, hipStream_t stream) {
    static int grid = 0;
    if (grid == 0) {
        if (n_in != 28 || out_size != T_TOK * DM || ws_size < WS_END) { fprintf(stderr, "kernel_launch: unexpected shapes (n_in %d out %d ws %zu)\n", n_in, out_size, ws_size); grid = -1; return; }
        int dev = 0, cus = 0;
        if (hipGetDevice(&dev) != hipSuccess || hipDeviceGetAttribute(&cus, hipDeviceAttributeMultiprocessorCount, dev) != hipSuccess) { grid = -1; return; }
        if (hipFuncSetAttribute((const void*)mk_fwd, hipFuncAttributeMaxDynamicSharedMemorySize, LDS_BYTES) != hipSuccess) { fprintf(stderr, "kernel_launch: hipFuncSetAttribute failed\n"); grid = -1; return; }
        (void)hipGetLastError();
        grid = cus;
    }
    if (grid < 0) return;
    if (hipMemsetAsync((char*)d_ws + WS_CTL, 0, CTL_ZERO_BYTES, stream) != hipSuccess) return;
    Args a{};
    for (int i = 0; i < 28; ++i) a.in[i] = (const float*)d_in[i];
    a.out = (float*)d_out; a.ws = (unsigned char*)d_ws;
    if (MK_N_LAUNCHES == 1) {
        a.ph_lo = 0; a.ph_hi = NPH_USED; a.li = 0;
        hipLaunchKernelGGL(mk_fwd, dim3(grid), dim3(NWAVES * 64), LDS_BYTES, stream, a);
    } else {
        for (int p = 0; p < NPH_USED; ++p) { a.ph_lo = p; a.ph_hi = p + 1; a.li = 0; hipLaunchKernelGGL(mk_fwd, dim3(grid), dim3(NWAVES * 64), LDS_BYTES, stream, a); }
    }
}
```
